# Optimizing an MI355X kernel written in HIP

```python
import jax, jax.numpy as jnp
from jax import lax
import numpy as np

D_MODEL = 2048
BATCH = 1
SEQ = 8192
DEPTH = 1

CHUNK = 64
M_HEADS = 4
M_QK_DIM = 128
M_V_DIM = 256
M_CONV = 4
A_HEADS = 8
A_HEAD_DIM = 128
A_PAST_CHUNKS = 8
A_MAX_REL = 128
D_FF = 5632
FFN_CONV = 3

EPS = 1e-6
NEG = -1e30

M_QK = M_HEADS * M_QK_DIM
M_V = M_HEADS * M_V_DIM
A_W = A_HEADS * A_HEAD_DIM
SPLITS = (M_QK, M_QK, M_V, M_V, M_HEADS, M_HEADS, A_W, A_W, A_W, D_MODEL, D_MODEL)
PROJ_WIDTH = sum(SPLITS)

kernel_name = "hybrid_mlstm_chunkattn_convffn"


def rmsnorm(x, g):
    xf = x.astype(jnp.float32)
    y = xf * lax.rsqrt(jnp.mean(xf * xf, axis=-1, keepdims=True) + EPS)
    return (y * g.astype(jnp.float32)).astype(x.dtype)


def causal_dwconv(x, w, b):
    K = w.shape[0]
    S = x.shape[1]
    xp = jnp.pad(x, ((0, 0), (K - 1, 0), (0, 0)))
    y = b
    for tap in range(K):
        y = y + xp[:, tap:tap + S] * w[tap]
    return y


def to_heads(t, n_heads):
    B, S, _ = t.shape
    return t.reshape(B, S, n_heads, -1).transpose(0, 2, 1, 3)


def from_heads(t):
    B, H, S, d = t.shape
    return t.transpose(0, 2, 1, 3).reshape(B, S, H * d)


def mlstm_chunkwise(q, k, v, li, lf):
    B, H, S, dk = q.shape
    dv = v.shape[-1]
    L = CHUNK
    NC = S // L
    q = q.reshape(B, H, NC, L, dk)
    k = k.reshape(B, H, NC, L, dk)
    v = v.reshape(B, H, NC, L, dv)
    li = li.reshape(B, H, NC, L)
    lf = lf.reshape(B, H, NC, L)
    b = jnp.cumsum(lf, axis=-1)
    b_tot = b[..., -1]
    causal = jnp.tril(jnp.ones((L, L), dtype=bool))
    d_log = jnp.where(causal, b[..., :, None] - b[..., None, :] + li[..., None, :], NEG)
    w_log = b_tot[..., None] - b + li
    m_loc = jnp.max(w_log, axis=-1)
    wk = jnp.exp(w_log - m_loc[..., None])[..., None] * k
    c_loc = jnp.einsum('bhcsk,bhcsv->bhckv', wk, v)
    n_loc = jnp.sum(wk, axis=3)

    def step(carry, inp):
        c_st, n_st, m_st = carry
        c_l, n_l, m_l, bt = inp
        m_new = jnp.maximum(bt + m_st, m_l)
        a = jnp.exp(bt + m_st - m_new)
        cl = jnp.exp(m_l - m_new)
        c_new = a[..., None, None] * c_st + cl[..., None, None] * c_l
        n_new = a[..., None] * n_st + cl[..., None] * n_l
        return (c_new, n_new, m_new), (c_st, n_st, m_st)

    init = (jnp.zeros((B, H, dk, dv), jnp.float32),
            jnp.zeros((B, H, dk), jnp.float32),
            jnp.full((B, H), NEG, jnp.float32))
    xs = (jnp.moveaxis(c_loc, 2, 0), jnp.moveaxis(n_loc, 2, 0),
          jnp.moveaxis(m_loc, 2, 0), jnp.moveaxis(b_tot, 2, 0))
    _, (c_prev, n_prev, m_prev) = lax.scan(step, init, xs)
    c_prev = jnp.moveaxis(c_prev, 0, 2)
    n_prev = jnp.moveaxis(n_prev, 0, 2)
    m_prev = jnp.moveaxis(m_prev, 0, 2)

    inter_log = b + m_prev[..., None]
    m_t = jnp.maximum(jnp.max(d_log, axis=-1), inter_log)
    p = jnp.exp(d_log - m_t[..., None]) * jnp.einsum('bhctk,bhcsk->bhcts', q, k)
    a_inter = jnp.exp(inter_log - m_t)
    num = jnp.einsum('bhcts,bhcsv->bhctv', p, v) + a_inter[..., None] * jnp.einsum('bhctk,bhckv->bhctv', q, c_prev)
    den = jnp.sum(p, axis=-1) + a_inter * jnp.einsum('bhctk,bhck->bhct', q, n_prev)
    h = num / jnp.maximum(jnp.abs(den), jnp.exp(-m_t))[..., None]
    return h.reshape(B, H, S, dv)


def chunk_band_attention(q, k, v, rel_table):
    B, H, S, dh = q.shape
    L = CHUNK
    NC = S // L
    W = A_PAST_CHUNKS + 1
    qc = q.reshape(B, H, NC, L, dh)
    pad = ((0, 0), (0, 0), (A_PAST_CHUNKS, 0), (0, 0), (0, 0))
    kp = jnp.pad(k.reshape(B, H, NC, L, dh), pad)
    vp = jnp.pad(v.reshape(B, H, NC, L, dh), pad)
    idx = jnp.arange(NC)[:, None] + jnp.arange(W)[None, :]
    kb = kp[:, :, idx].reshape(B, H, NC, W * L, dh)
    vb = vp[:, :, idx].reshape(B, H, NC, W * L, dh)
    s = jnp.einsum('bhcqd,bhckd->bhcqk', qc, kb).astype(jnp.float32) * (dh ** -0.5)
    qpos = A_PAST_CHUNKS * L + jnp.arange(L)
    kpos = jnp.arange(W * L)
    rel = jnp.clip(qpos[:, None] - kpos[None, :], -A_MAX_REL, A_MAX_REL) + A_MAX_REL
    bias = rel_table.astype(jnp.float32)[:, rel]
    valid = (jnp.arange(NC)[:, None] - A_PAST_CHUNKS + jnp.arange(W)[None, :]) >= 0
    valid = jnp.repeat(valid, L, axis=1)
    s = jnp.where(valid[None, None, :, None, :], s + bias[None, :, None], NEG)
    p = jax.nn.softmax(s, axis=-1).astype(v.dtype)
    o = jnp.einsum('bhcqk,bhckd->bhcqd', p, vb)
    return o.reshape(B, H, S, dh)


def setup_inputs(seed: int = 0) -> dict:
    key = jax.random.key(seed)
    ks = jax.random.split(key, 24)
    f32 = jnp.float32

    def nrm(k, shape, scale):
        return jax.random.normal(k, shape, f32) * scale

    return {
        "x": nrm(ks[0], (BATCH, SEQ, D_MODEL), 1.0),
        "norm_mix": 1.0 + nrm(ks[1], (DEPTH, D_MODEL), 0.02),
        "w_in": nrm(ks[2], (DEPTH, D_MODEL, PROJ_WIDTH), D_MODEL ** -0.5),
        "conv_qk_w": nrm(ks[3], (DEPTH, M_CONV, 2 * M_QK), M_CONV ** -0.5),
        "conv_qk_b": nrm(ks[4], (DEPTH, 2 * M_QK), 0.02),
        "b_igate": nrm(ks[5], (DEPTH, M_HEADS), 0.1),
        "b_fgate": jnp.linspace(3.0, 6.0, M_HEADS, dtype=f32)[None, :] + nrm(ks[6], (DEPTH, M_HEADS), 0.1),
        "m_norm": 1.0 + nrm(ks[7], (DEPTH, M_V), 0.02),
        "rel_bias": nrm(ks[8], (DEPTH, A_HEADS, 2 * A_MAX_REL + 1), 0.5),
        "gate_bias": nrm(ks[9], (DEPTH, 2, D_MODEL), 0.02),
        "w_branch_m": nrm(ks[10], (DEPTH, M_V, D_MODEL), M_V ** -0.5),
        "w_branch_a": nrm(ks[11], (DEPTH, A_W, D_MODEL), A_W ** -0.5),
        "w_out": nrm(ks[12], (DEPTH, D_MODEL, D_MODEL), D_MODEL ** -0.5),
        "norm_ffn": 1.0 + nrm(ks[13], (DEPTH, D_MODEL), 0.02),
        "w_up": nrm(ks[14], (DEPTH, D_MODEL, 2 * D_FF), D_MODEL ** -0.5),
        "conv_ffn_w": nrm(ks[15], (DEPTH, FFN_CONV, D_FF), FFN_CONV ** -0.5),
        "conv_ffn_b": nrm(ks[16], (DEPTH, D_FF), 0.02),
        "w_down": nrm(ks[17], (DEPTH, D_FF, D_MODEL), D_FF ** -0.5),
        "norm_final": 1.0 + nrm(ks[18], (D_MODEL,), 0.02),
    }


def reference(x, norm_mix, w_in, conv_qk_w, conv_qk_b, b_igate, b_fgate, m_norm, rel_bias,
              gate_bias, w_branch_m, w_branch_a, w_out, norm_ffn, w_up, conv_ffn_w, conv_ffn_b,
              w_down, norm_final):
    f32 = jnp.float32
    split_idx = [int(i) for i in np.cumsum(SPLITS)[:-1]]
    for l in range(DEPTH):
        h = rmsnorm(x, norm_mix[l])
        proj = h @ w_in[l]
        mq, mk, mv, mo, mi, mf, aq, ak, av, g_m, g_a = jnp.split(proj, split_idx, axis=-1)

        qk = jax.nn.silu(causal_dwconv(jnp.concatenate([mq, mk], axis=-1), conv_qk_w[l], conv_qk_b[l]))
        mq, mk = jnp.split(qk, 2, axis=-1)
        q_h = to_heads(mq, M_HEADS).astype(f32)
        k_h = to_heads(mk, M_HEADS).astype(f32) * (M_QK_DIM ** -0.5)
        v_h = to_heads(mv, M_HEADS).astype(f32)
        li = (mi.astype(f32) + b_igate[l].astype(f32)).transpose(0, 2, 1)
        lf = jax.nn.log_sigmoid(mf.astype(f32) + b_fgate[l].astype(f32)).transpose(0, 2, 1)
        hm = mlstm_chunkwise(q_h, k_h, v_h, li, lf)
        hm = hm * lax.rsqrt(jnp.mean(hm * hm, axis=-1, keepdims=True) + EPS)
        hm = from_heads(hm) * m_norm[l].astype(f32)
        hm = (hm * jax.nn.sigmoid(mo.astype(f32))).astype(x.dtype)
        y_m = hm @ w_branch_m[l]

        ha = chunk_band_attention(to_heads(aq, A_HEADS), to_heads(ak, A_HEADS), to_heads(av, A_HEADS), rel_bias[l])
        y_a = from_heads(ha) @ w_branch_a[l]

        merged = jax.nn.sigmoid(g_m + gate_bias[l, 0]) * y_m + jax.nn.sigmoid(g_a + gate_bias[l, 1]) * y_a
        x = x + merged @ w_out[l]

        h = rmsnorm(x, norm_ffn[l])
        u_gate, u_val = jnp.split(h @ w_up[l], 2, axis=-1)
        u_gate = causal_dwconv(u_gate, conv_ffn_w[l], conv_ffn_b[l])
        x = x + (jax.nn.silu(u_gate) * u_val) @ w_down[l]
    return rmsnorm(x, norm_final)
```

```cpp
#include <hip/hip_runtime.h>
#include <cstdint>
#include <cstdio>

typedef unsigned short bf16;
typedef short bf16x8 __attribute__((ext_vector_type(8)));
typedef float f32x4 __attribute__((ext_vector_type(4)));
typedef unsigned u32x4 __attribute__((ext_vector_type(4)));
typedef unsigned u32x2 __attribute__((ext_vector_type(2)));

constexpr int S = 8192, D = 2048, WIN_N = 10248, NP = 10240, DFF = 5632, NUP = 11264;
constexpr int CH = 64, NCH = 128;
constexpr int MH = 4, MDK = 128, MDV = 256, AH = 8, ADH = 128;
constexpr int C_MQ = 0, C_MK = 512, C_MV = 1024, C_MO = 2048, C_AQ = 3072, C_AK = 4096, C_AV = 5120, C_GM = 6144, C_GA = 8192;
constexpr float EPS = 1e-6f, NEGF = -1e30f;

constexpr size_t MiB = 1u << 20;
constexpr size_t WS_WIN = 0;
constexpr size_t WS_XN = 40 * MiB;
constexpr size_t WS_QC = 0;
constexpr size_t WS_KC = 8 * MiB;
constexpr size_t WS_A2 = 0;
constexpr size_t WS_MRG = 32 * MiB;
constexpr size_t WS_ACT = 0;
constexpr size_t WS_WM = 72 * MiB, WS_WA = 76 * MiB, WS_WO = 80 * MiB, WS_WUP = 88 * MiB, WS_WDN = 132 * MiB;
constexpr size_t WS_PROJ = 154 * MiB;
constexpr size_t WS_HM = 314 * MiB, WS_HA = 330 * MiB;
constexpr size_t WS_U = 154 * MiB;
constexpr size_t WS_MISC = 346 * MiB;
constexpr size_t WS_LI = WS_MISC, WS_LF = WS_LI + 131072, WS_MLOC = WS_LF + 131072, WS_BTOT = WS_MLOC + 2048, WS_MPREV = WS_BTOT + 2048,
                 WS_NLOC = WS_MPREV + 2048, WS_NPREV = WS_NLOC + 262144, WS_RS2 = WS_NPREV + 262144, WS_END = WS_RS2 + 32768;
static_assert(WS_END <= 348 * MiB, "ws map");

__device__ __forceinline__ unsigned f2bf(float f) { unsigned u = __builtin_bit_cast(unsigned, f); return (u + 0x7fffu + ((u >> 16) & 1u)) >> 16; }
__device__ __forceinline__ float bf2f(unsigned short b) { return __builtin_bit_cast(float, (unsigned)b << 16); }
__device__ __forceinline__ unsigned pk2(float lo, float hi) { return f2bf(lo) | (f2bf(hi) << 16); }
__device__ __forceinline__ float wave_sum(float v) {
#pragma unroll
    for (int o = 1; o < 64; o <<= 1) v += __shfl_xor(v, o);
    return v;
}
__device__ __forceinline__ float wave_max(float v) {
#pragma unroll
    for (int o = 1; o < 64; o <<= 1) v = fmaxf(v, __shfl_xor(v, o));
    return v;
}
__device__ __forceinline__ float sigmoidf_(float x) { return 1.f / (1.f + __expf(-x)); }

__device__ __forceinline__ int src_col(int mode, int n0) {
    if (mode == 1) return n0 < 3072 ? n0 : n0 + 8;
    if (mode == 2) { const int j = n0 >> 8, i = n0 & 255; return i < 128 ? 128 * j + i : DFF + 128 * j + (i - 128); }
    return n0;
}
__device__ __forceinline__ void transpose_item(const float* W, int K, int Nsrc, int Ndst, bf16* WT, int mode, float* scr, int item, int lane) {
    const int nblk = Ndst / 32, kb = item / nblk, nb = item % nblk, k0 = 64 * kb, n0 = 32 * nb, s0 = src_col(mode, n0);
#pragma unroll 8
    for (int i = 0; i < 32; ++i) { const int kk = 2 * i + (lane >> 5); scr[kk * 33 + (lane & 31)] = W[(size_t)(k0 + kk) * Nsrc + s0 + (lane & 31)]; }
    __builtin_amdgcn_s_waitcnt(0xc07f); asm volatile("" ::: "memory");
    const int c = lane & 7;
#pragma unroll
    for (int j = 0; j < 4; ++j) { const int n = (lane >> 3) + 8 * j; const float* s = scr + (8 * c) * 33 + n;
        u32x4 o; o.x = pk2(s[0 * 33], s[1 * 33]); o.y = pk2(s[2 * 33], s[3 * 33]); o.z = pk2(s[4 * 33], s[5 * 33]); o.w = pk2(s[6 * 33], s[7 * 33]);
        *(u32x4*)(WT + (size_t)(n0 + n) * K + k0 + 8 * c) = o; }
    __builtin_amdgcn_s_waitcnt(0xc07f); asm volatile("" ::: "memory");
}
struct Ptrs {
    const float* in[19]; float* out; unsigned char* ws;
};
constexpr int IT_WIN = (D / 64) * (NP / 32), IT_WM = (1024 / 64) * (D / 32), IT_WO = (D / 64) * (D / 32), IT_WUP = (D / 64) * (NUP / 32), IT_WDN = (DFF / 64) * (D / 32);
constexpr int IT_TOTAL = IT_WIN + 2 * IT_WM + IT_WO + IT_WUP + IT_WDN;

__global__ void __launch_bounds__(256) k_transpose(Ptrs p) {
    __shared__ float scr_all[4 * 64 * 33];
    const int lane = threadIdx.x & 63, wave = threadIdx.x >> 6;
    float* scr = scr_all + wave * 64 * 33;
    const int gw = blockIdx.x * 4 + wave, NGW = gridDim.x * 4;
    for (int it = gw; it < IT_TOTAL; it += NGW) {
        int r = it;
        if (r < IT_WIN) { transpose_item(p.in[2], D, WIN_N, NP, (bf16*)(p.ws + WS_WIN), 1, scr, r, lane); continue; } r -= IT_WIN;
        if (r < IT_WM) { transpose_item(p.in[10], 1024, D, D, (bf16*)(p.ws + WS_WM), 0, scr, r, lane); continue; } r -= IT_WM;
        if (r < IT_WM) { transpose_item(p.in[11], 1024, D, D, (bf16*)(p.ws + WS_WA), 0, scr, r, lane); continue; } r -= IT_WM;
        if (r < IT_WO) { transpose_item(p.in[12], D, D, D, (bf16*)(p.ws + WS_WO), 0, scr, r, lane); continue; } r -= IT_WO;
        if (r < IT_WUP) { transpose_item(p.in[14], D, NUP, NUP, (bf16*)(p.ws + WS_WUP), 2, scr, r, lane); continue; } r -= IT_WUP;
        transpose_item(p.in[17], DFF, D, D, (bf16*)(p.ws + WS_WDN), 0, scr, r, lane);
    }
}

__global__ void __launch_bounds__(512) k_norm_gates(Ptrs p) {
    extern __shared__ __attribute__((aligned(16))) unsigned char lds[];
    float* wgs = (float*)lds;
    const float* w_in = p.in[2];
    for (int i = threadIdx.x; i < 2048 * 8; i += 512) wgs[i] = w_in[(size_t)(i >> 3) * WIN_N + 3072 + (i & 7)];
    __syncthreads();
    const int lane = threadIdx.x & 63, wave = threadIdx.x >> 6;
    const int gw = blockIdx.x * 8 + wave, NGW = gridDim.x * 8;
    const float* x = p.in[0]; const f32x4* g4 = (const f32x4*)p.in[1];
    bf16* XN = (bf16*)(p.ws + WS_XN); float* LI = (float*)(p.ws + WS_LI); float* LF = (float*)(p.ws + WS_LF);
    for (int row = gw; row < S; row += NGW) {
        const f32x4* xr = (const f32x4*)(x + (size_t)row * D);
        float ss = 0.f;
#pragma unroll
        for (int j = 0; j < 8; ++j) { const f32x4 v = xr[64 * j + lane]; ss += (v.x * v.x + v.y * v.y) + (v.z * v.z + v.w * v.w); }
        const float r = rsqrtf(wave_sum(ss) * (1.f / D) + EPS);
        float d0 = 0.f, d1 = 0.f, d2 = 0.f, d3 = 0.f, d4 = 0.f, d5 = 0.f, d6 = 0.f, d7 = 0.f;
#pragma unroll 1
        for (int j = 0; j < 8; ++j) {
            const f32x4 g = g4[64 * j + lane]; const f32x4 hv = xr[64 * j + lane] * r * g;
            *(u32x2*)(XN + (size_t)row * D + 4 * (64 * j + lane)) = (u32x2){pk2(hv.x, hv.y), pk2(hv.z, hv.w)};
            const float* w = wgs + (size_t)(4 * (64 * j + lane)) * 8;
#pragma unroll
            for (int e = 0; e < 4; ++e) { const f32x4 w0 = *(const f32x4*)(w + 8 * e), w1 = *(const f32x4*)(w + 8 * e + 4);
                const float hh = e == 0 ? hv.x : e == 1 ? hv.y : e == 2 ? hv.z : hv.w;
                d0 += hh * w0.x; d1 += hh * w0.y; d2 += hh * w0.z; d3 += hh * w0.w;
                d4 += hh * w1.x; d5 += hh * w1.y; d6 += hh * w1.z; d7 += hh * w1.w; }
        }
        float dots[8] = {d0, d1, d2, d3, d4, d5, d6, d7};
#pragma unroll
        for (int q = 0; q < 8; ++q) dots[q] = wave_sum(dots[q]);
        if (lane < 4) { float dv = lane == 0 ? dots[0] : lane == 1 ? dots[1] : lane == 2 ? dots[2] : dots[3]; LI[lane * S + row] = dv + p.in[5][lane]; }
        else if (lane < 8) { const int hh = lane - 4; float dv = hh == 0 ? dots[4] : hh == 1 ? dots[5] : hh == 2 ? dots[6] : dots[7];
            const float z = dv + p.in[6][hh]; const float ee = __expf(-fabsf(z)), uu = 1.f + ee; const float l1p = (uu == 1.f) ? ee : __logf(uu) * (ee / (uu - 1.f)); LF[hh * S + row] = fminf(z, 0.f) - l1p; }
    }
}

template <class Epi, bool DUAL>
__global__ void __launch_bounds__(256) k_gemm(const bf16* A, int lda, const bf16* Bt, int ldb, const bf16* A2, int lda2, const bf16* Bt2, int ldb2, int K, Epi epi) {
    const int wave = threadIdx.x >> 6, lane = threadIdx.x & 63, fr = lane & 15, fq = lane >> 4;
    const int row0 = blockIdx.y * 128 + (wave >> 1) * 64, col0 = blockIdx.x * 128 + (wave & 1) * 64;
    f32x4 acc[4][4], acc2[4][4];
#pragma unroll
    for (int i = 0; i < 4; ++i)
#pragma unroll
        for (int j = 0; j < 4; ++j) { acc[i][j] = (f32x4){0.f, 0.f, 0.f, 0.f}; acc2[i][j] = (f32x4){0.f, 0.f, 0.f, 0.f}; }
    for (int k0 = 0; k0 < K; k0 += 32) {
        bf16x8 a[4], b[4];
#pragma unroll
        for (int i = 0; i < 4; ++i) a[i] = *(const bf16x8*)(A + (size_t)(row0 + 16 * i + fr) * lda + k0 + 8 * fq);
#pragma unroll
        for (int j = 0; j < 4; ++j) b[j] = *(const bf16x8*)(Bt + (size_t)(col0 + 16 * j + fr) * ldb + k0 + 8 * fq);
#pragma unroll
        for (int i = 0; i < 4; ++i)
#pragma unroll
            for (int j = 0; j < 4; ++j) acc[i][j] = __builtin_amdgcn_mfma_f32_16x16x32_bf16(a[i], b[j], acc[i][j], 0, 0, 0);
        if constexpr (DUAL) {
#pragma unroll
            for (int i = 0; i < 4; ++i) a[i] = *(const bf16x8*)(A2 + (size_t)(row0 + 16 * i + fr) * lda2 + k0 + 8 * fq);
#pragma unroll
            for (int j = 0; j < 4; ++j) b[j] = *(const bf16x8*)(Bt2 + (size_t)(col0 + 16 * j + fr) * ldb2 + k0 + 8 * fq);
#pragma unroll
            for (int i = 0; i < 4; ++i)
#pragma unroll
                for (int j = 0; j < 4; ++j) acc2[i][j] = __builtin_amdgcn_mfma_f32_16x16x32_bf16(a[i], b[j], acc2[i][j], 0, 0, 0);
        }
    }
#pragma unroll
    for (int i = 0; i < 4; ++i)
#pragma unroll
        for (int j = 0; j < 4; ++j)
#pragma unroll
            for (int e = 0; e < 4; ++e) epi(row0 + 16 * i + 4 * fq + e, col0 + 16 * j + fr, acc[i][j][e], acc2[i][j][e]);
}
struct EpiStoreBf16 { bf16* O; int ldc; int pad;
    __device__ __forceinline__ void operator()(int r, int c, float v, float) const { O[(size_t)r * ldc + c] = (bf16)f2bf(v); } };
struct EpiMerge { const bf16* P; const float* gb; bf16* O;
    __device__ __forceinline__ void operator()(int r, int c, float ym, float ya) const {
        const float gm = bf2f(P[(size_t)r * NP + C_GM + c]) + gb[c], ga = bf2f(P[(size_t)r * NP + C_GA + c]) + gb[D + c];
        O[(size_t)r * D + c] = (bf16)f2bf(sigmoidf_(gm) * ym + sigmoidf_(ga) * ya); } };
struct EpiResid1 { const float* x; float* out; bf16* A2; const float* g;
    __device__ __forceinline__ void operator()(int r, int c, float v, float) const {
        const float x1 = x[(size_t)r * D + c] + v; out[(size_t)r * D + c] = x1; A2[(size_t)r * D + c] = (bf16)f2bf(x1 * g[c]); } };
struct EpiResid2 { float* out;
    __device__ __forceinline__ void operator()(int r, int c, float v, float) const { out[(size_t)r * D + c] += v; } };

__global__ void __launch_bounds__(256) k_attn_naive(Ptrs p) {
    __shared__ float sc[16][576];
    __shared__ float qs[16][128];
    const int qg = blockIdx.x, c = blockIdx.y, h = blockIdx.z, tid = threadIdx.x, lane = tid & 63, wave = tid >> 6;
    const bf16* P = (const bf16*)(p.ws + WS_PROJ); bf16* HA = (bf16*)(p.ws + WS_HA);
    const float* bias = p.in[8] + h * 257;
    const int t0 = c * 64 + qg * 16;
    { const int row = tid >> 4, d0 = (tid & 15) * 8; const bf16x8 q = *(const bf16x8*)(P + (size_t)(t0 + row) * NP + C_AQ + h * 128 + d0);
#pragma unroll
      for (int e = 0; e < 8; ++e) qs[row][d0 + e] = bf2f((unsigned short)q[e]); }
    __syncthreads();
    for (int kk = tid; kk < 576; kk += 256) {
        const int kpos = (c - 8) * 64 + kk;
        float acc[16];
#pragma unroll
        for (int i = 0; i < 16; ++i) acc[i] = 0.f;
        if (kpos >= 0) {
            const bf16* kr = P + (size_t)kpos * NP + C_AK + h * 128;
            for (int d0 = 0; d0 < 16; ++d0) { const bf16x8 kv = *(const bf16x8*)(kr + d0 * 8); float kf[8];
#pragma unroll
                for (int e = 0; e < 8; ++e) kf[e] = bf2f((unsigned short)kv[e]);
#pragma unroll
                for (int i = 0; i < 16; ++i)
#pragma unroll
                    for (int e = 0; e < 8; ++e) acc[i] += qs[i][d0 * 8 + e] * kf[e]; }
        }
#pragma unroll
        for (int i = 0; i < 16; ++i) {
            float s = NEGF;
            if (kpos >= 0) { int rel = (512 + qg * 16 + i) - kk; rel = rel < -128 ? -128 : (rel > 128 ? 128 : rel); s = acc[i] * 0.08838834764831845f + bias[rel + 128]; }
            sc[i][kk] = s; }
    }
    __syncthreads();
    for (int rr = 0; rr < 4; ++rr) { const int row = wave * 4 + rr; float m = NEGF;
        for (int i = 0; i < 9; ++i) m = fmaxf(m, sc[row][lane + 64 * i]);
        m = wave_max(m); float sum = 0.f;
        for (int i = 0; i < 9; ++i) { const float e = __expf(sc[row][lane + 64 * i] - m); sc[row][lane + 64 * i] = e; sum += e; }
        sum = wave_sum(sum); const float inv = 1.f / sum;
        for (int i = 0; i < 9; ++i) sc[row][lane + 64 * i] *= inv; }
    __syncthreads();
    { const int d = tid & 127, half = tid >> 7; float acc[8];
#pragma unroll
      for (int i = 0; i < 8; ++i) acc[i] = 0.f;
      for (int kk = 0; kk < 576; ++kk) { const int kpos = (c - 8) * 64 + kk; if (kpos < 0) continue;
          const float v = bf2f(P[(size_t)kpos * NP + C_AV + h * 128 + d]);
#pragma unroll
          for (int i = 0; i < 8; ++i) acc[i] += sc[half * 8 + i][kk] * v; }
#pragma unroll
      for (int i = 0; i < 8; ++i) HA[(size_t)(t0 + half * 8 + i) * 1024 + h * 128 + d] = (bf16)f2bf(acc[i]); }
}

__global__ void __launch_bounds__(256) k_mlstm_local_naive(Ptrs p) {
    __shared__ float ks[64][128];
    __shared__ float bsh[64], wsh[64];
    const int c = blockIdx.x, h = blockIdx.y, tid = threadIdx.x, t0 = c * 64;
    const bf16* P = (const bf16*)(p.ws + WS_PROJ); bf16* QC = (bf16*)(p.ws + WS_QC); bf16* KC = (bf16*)(p.ws + WS_KC);
    const float* cw = p.in[3]; const float* cb = p.in[4];
    const float* LI = (const float*)(p.ws + WS_LI); const float* LF = (const float*)(p.ws + WS_LF);
    for (int idx = tid; idx < 2 * 64 * 128; idx += 256) {
        const int which = idx >> 13, rem = idx & 8191, t = rem >> 7, ch = rem & 127, gch = which * 512 + h * 128 + ch;
        float a = cb[gch];
#pragma unroll
        for (int tap = 0; tap < 4; ++tap) { const int tt = t0 + t - 3 + tap; if (tt >= 0) a += cw[tap * 1024 + gch] * bf2f(P[(size_t)tt * NP + gch]); }
        float y = a * sigmoidf_(a);
        if (which == 0) QC[(size_t)(t0 + t) * 512 + h * 128 + ch] = (bf16)f2bf(y);
        else { y *= 0.08838834764831845f; const unsigned short b = (unsigned short)f2bf(y); KC[(size_t)(t0 + t) * 512 + h * 128 + ch] = b; ks[t][ch] = bf2f(b); }
    }
    if (tid == 0) {
        float run = 0.f;
        for (int s = 0; s < 64; ++s) { run += LF[h * S + t0 + s]; bsh[s] = run; }
        const float btot = run; float m = -INFINITY;
        for (int s = 0; s < 64; ++s) { const float wl = btot - bsh[s] + LI[h * S + t0 + s]; wsh[s] = wl; m = fmaxf(m, wl); }
        for (int s = 0; s < 64; ++s) wsh[s] = __expf(wsh[s] - m);
        ((float*)(p.ws + WS_MLOC))[h * 128 + c] = m; ((float*)(p.ws + WS_BTOT))[h * 128 + c] = btot;
    }
    __syncthreads();
    { const int dv = tid; float vw[64];
#pragma unroll
      for (int s = 0; s < 64; ++s) vw[s] = bf2f(P[(size_t)(t0 + s) * NP + C_MV + h * 256 + dv]) * wsh[s];
      float* CL = p.out + ((size_t)(h * 128 + c) * 256 + dv) * 128;
      for (int dk = 0; dk < 128; ++dk) { float sum = 0.f;
#pragma unroll
          for (int s = 0; s < 64; ++s) sum += vw[s] * ks[s][dk];
          CL[dk] = sum; } }
    if (tid < 128) { float sum = 0.f; for (int s = 0; s < 64; ++s) sum += wsh[s] * ks[s][tid]; ((float*)(p.ws + WS_NLOC))[(h * 128 + c) * 128 + tid] = sum; }
}

__global__ void __launch_bounds__(512) k_scan(Ptrs p) {
    const int tid = threadIdx.x, h = blockIdx.x >> 6, rest = ((blockIdx.x & 63) << 9) + tid;
    float* CL = p.out; const float* MLOC = (const float*)(p.ws + WS_MLOC); const float* BTOT = (const float*)(p.ws + WS_BTOT);
    float* MPREV = (float*)(p.ws + WS_MPREV); const float* NLOC = (const float*)(p.ws + WS_NLOC); float* NPREV = (float*)(p.ws + WS_NPREV);
    const bool nthr = ((blockIdx.x & 63) == 0) && tid < 128, mthr = ((blockIdx.x & 63) == 0) && tid == 0;
    float m = NEGF, st = 0.f, nst = 0.f;
    for (int c0 = 0; c0 < NCH; c0 += 8) {
        float val[8], nv[8];
#pragma unroll
        for (int i = 0; i < 8; ++i) { val[i] = CL[((size_t)(h * 128 + c0 + i) << 15) + rest]; nv[i] = nthr ? NLOC[(h * 128 + c0 + i) * 128 + tid] : 0.f; }
#pragma unroll
        for (int i = 0; i < 8; ++i) { const int c = c0 + i;
            const float bt = BTOT[h * 128 + c], ml = MLOC[h * 128 + c];
            CL[((size_t)(h * 128 + c) << 15) + rest] = st;
            if (nthr) NPREV[(h * 128 + c) * 128 + tid] = nst;
            if (mthr) MPREV[h * 128 + c] = m;
            const float mn = fmaxf(bt + m, ml), a = __expf(bt + m - mn), cl = __expf(ml - mn);
            st = a * st + cl * val[i]; nst = a * nst + cl * nv[i]; m = mn; }
    }
}

__global__ void __launch_bounds__(256) k_mlstm_out_naive(Ptrs p) {
    extern __shared__ __attribute__((aligned(16))) unsigned char lds[];
    float (*qs)[128] = (float (*)[128])lds;
    float (*ps)[64] = (float (*)[64])(lds + 32768);
    float* bsh = (float*)(lds + 49152); float* lish = bsh + 64; float* ash = lish + 64; float* dsh = ash + 64; float* red = dsh + 64;
    const int c = blockIdx.x, h = blockIdx.y, tid = threadIdx.x, t0 = c * 64, lane = tid & 63, wave = tid >> 6;
    const bf16* P = (const bf16*)(p.ws + WS_PROJ); const bf16* QC = (const bf16*)(p.ws + WS_QC); const bf16* KC = (const bf16*)(p.ws + WS_KC);
    const float* LI = (const float*)(p.ws + WS_LI); const float* LF = (const float*)(p.ws + WS_LF);
    for (int i = tid; i < 64 * 16; i += 256) { const int t = i >> 4, d0 = (i & 15) * 8; const bf16x8 q = *(const bf16x8*)(QC + (size_t)(t0 + t) * 512 + h * 128 + d0);
#pragma unroll
        for (int e = 0; e < 8; ++e) qs[t][d0 + e] = bf2f((unsigned short)q[e]); }
    if (tid == 0) { float run = 0.f; for (int s = 0; s < 64; ++s) { run += LF[h * S + t0 + s]; bsh[s] = run; lish[s] = LI[h * S + t0 + s]; } }
    __syncthreads();
    const float mprev = ((const float*)(p.ws + WS_MPREV))[h * 128 + c];
    { const int t = tid >> 2, sg = tid & 3; float dot[16]; float mt = bsh[t] + mprev;
#pragma unroll
      for (int si = 0; si < 16; ++si) { const int s = sg * 16 + si; float a = 0.f; const bf16* kr = KC + (size_t)(t0 + s) * 512 + h * 128;
#pragma unroll 1
          for (int d0 = 0; d0 < 16; ++d0) { const bf16x8 kv = *(const bf16x8*)(kr + d0 * 8);
#pragma unroll
              for (int e = 0; e < 8; ++e) a += qs[t][d0 * 8 + e] * bf2f((unsigned short)kv[e]); }
          dot[si] = a; if (s <= t) mt = fmaxf(mt, bsh[t] - bsh[s] + lish[s]); }
      mt = fmaxf(mt, __shfl_xor(mt, 1)); mt = fmaxf(mt, __shfl_xor(mt, 2));
      float psum = 0.f;
#pragma unroll
      for (int si = 0; si < 16; ++si) { const int s = sg * 16 + si; const float pv = (s <= t) ? __expf(bsh[t] - bsh[s] + lish[s] - mt) * dot[si] : 0.f; ps[t][s] = pv; psum += pv; }
      psum += __shfl_xor(psum, 1); psum += __shfl_xor(psum, 2);
      const float* np = (const float*)(p.ws + WS_NPREV) + (h * 128 + c) * 128; float qn = 0.f;
      for (int dk = sg * 32; dk < sg * 32 + 32; ++dk) qn += qs[t][dk] * np[dk];
      qn += __shfl_xor(qn, 1); qn += __shfl_xor(qn, 2);
      const float ai = __expf(bsh[t] + mprev - mt), den = psum + ai * qn;
      if (sg == 0) { ash[t] = ai; dsh[t] = fmaxf(fabsf(den), __expf(-mt)); } }
    __syncthreads();
    const int dv = tid;
    const float mn = p.in[7][h * 256 + dv];
    bf16* HM = (bf16*)(p.ws + WS_HM);
    const float* cp = p.out + ((size_t)(h * 128 + c) * 256 + dv) * 128;
#pragma unroll 1
    for (int th = 0; th < 4; ++th) {
        float ainter[16], aintra[16];
#pragma unroll
        for (int t = 0; t < 16; ++t) { ainter[t] = 0.f; aintra[t] = 0.f; }
#pragma unroll 1
        for (int dk0 = 0; dk0 < 128; dk0 += 4) { const f32x4 c4 = *(const f32x4*)(cp + dk0);
#pragma unroll
            for (int t = 0; t < 16; ++t) { const f32x4 q4 = *(const f32x4*)(&qs[th * 16 + t][dk0]); ainter[t] += (q4.x * c4.x + q4.y * c4.y) + (q4.z * c4.z + q4.w * c4.w); } }
#pragma unroll 1
        for (int s0 = 0; s0 < 64; s0 += 4) { float vv[4];
#pragma unroll
            for (int e = 0; e < 4; ++e) vv[e] = bf2f(P[(size_t)(t0 + s0 + e) * NP + C_MV + h * 256 + dv]);
#pragma unroll
            for (int t = 0; t < 16; ++t) { const f32x4 p4 = *(const f32x4*)(&ps[th * 16 + t][s0]); aintra[t] += (p4.x * vv[0] + p4.y * vv[1]) + (p4.z * vv[2] + p4.w * vv[3]); } }
        float hv[16];
#pragma unroll
        for (int t = 0; t < 16; ++t) { hv[t] = (aintra[t] + ash[th * 16 + t] * ainter[t]) / dsh[th * 16 + t]; const float ss = wave_sum(hv[t] * hv[t]); if (lane == 0) red[wave * 64 + th * 16 + t] = ss; }
        __syncthreads();
#pragma unroll
        for (int t = 0; t < 16; ++t) { const int tt = th * 16 + t; const float ss = (red[tt] + red[64 + tt]) + (red[128 + tt] + red[192 + tt]); const float r = rsqrtf(ss * (1.f / 256.f) + EPS);
            const float o = bf2f(P[(size_t)(t0 + tt) * NP + C_MO + h * 256 + dv]);
            HM[(size_t)(t0 + tt) * 1024 + h * 256 + dv] = (bf16)f2bf(hv[t] * r * mn * sigmoidf_(o)); }
    }
}

__global__ void __launch_bounds__(512) k_rowstat(Ptrs p) {
    const int lane = threadIdx.x & 63, gw = blockIdx.x * 8 + (threadIdx.x >> 6), NGW = gridDim.x * 8;
    float* RS2 = (float*)(p.ws + WS_RS2);
    for (int row = gw; row < S; row += NGW) { const f32x4* xr = (const f32x4*)(p.out + (size_t)row * D); float ss = 0.f;
#pragma unroll
        for (int j = 0; j < 8; ++j) { const f32x4 v = xr[64 * j + lane]; ss += (v.x * v.x + v.y * v.y) + (v.z * v.z + v.w * v.w); }
        ss = wave_sum(ss); if (lane == 0) RS2[row] = rsqrtf(ss * (1.f / D) + EPS); }
}

__global__ void __launch_bounds__(512) k_ffn_conv(Ptrs p) {
    const int lane = threadIdx.x & 63, gw = blockIdx.x * 8 + (threadIdx.x >> 6), NGW = gridDim.x * 8;
    const bf16* U = (const bf16*)(p.ws + WS_U); bf16* ACT = (bf16*)(p.ws + WS_ACT); const float* RS2 = (const float*)(p.ws + WS_RS2);
    const float* cw = p.in[15]; const float* cb = p.in[16];
    constexpr int NCB = DFF / 512, NRB = S / 16;
    for (int unit = gw; unit < NCB * NRB; unit += NGW) {
        const int cbk = unit % NCB, rb = unit / NCB, ch0 = cbk * 512 + lane * 8, j = ch0 >> 7, i0 = ch0 & 127, gcol = 256 * j + i0, vcol = gcol + 128, r0 = rb * 16;
        float w0[8], w1[8], w2[8], bb[8], gm2[8], gm1[8];
#pragma unroll
        for (int e = 0; e < 8; ++e) { w0[e] = cw[ch0 + e]; w1[e] = cw[DFF + ch0 + e]; w2[e] = cw[2 * DFF + ch0 + e]; bb[e] = cb[ch0 + e]; gm2[e] = 0.f; gm1[e] = 0.f; }
        if (r0 >= 2) { const float ra = RS2[r0 - 2], rbv = RS2[r0 - 1];
            const bf16x8 a = *(const bf16x8*)(U + (size_t)(r0 - 2) * NUP + gcol), b = *(const bf16x8*)(U + (size_t)(r0 - 1) * NUP + gcol);
#pragma unroll
            for (int e = 0; e < 8; ++e) { gm2[e] = ra * bf2f((unsigned short)a[e]); gm1[e] = rbv * bf2f((unsigned short)b[e]); } }
        for (int t = r0; t < r0 + 16; ++t) { const float r = RS2[t];
            const bf16x8 g = *(const bf16x8*)(U + (size_t)t * NUP + gcol), v = *(const bf16x8*)(U + (size_t)t * NUP + vcol); float o[8];
#pragma unroll
            for (int e = 0; e < 8; ++e) { const float g0 = r * bf2f((unsigned short)g[e]); const float cv = bb[e] + w0[e] * gm2[e] + w1[e] * gm1[e] + w2[e] * g0;
                o[e] = cv * sigmoidf_(cv) * (r * bf2f((unsigned short)v[e])); gm2[e] = gm1[e]; gm1[e] = g0; }
            *(u32x4*)(ACT + (size_t)t * DFF + ch0) = (u32x4){pk2(o[0], o[1]), pk2(o[2], o[3]), pk2(o[4], o[5]), pk2(o[6], o[7])}; }
    }
}

__global__ void __launch_bounds__(512) k_final_norm(Ptrs p) {
    const int lane = threadIdx.x & 63, gw = blockIdx.x * 8 + (threadIdx.x >> 6), NGW = gridDim.x * 8;
    const f32x4* g4 = (const f32x4*)p.in[18];
    for (int row = gw; row < S; row += NGW) { f32x4* xr = (f32x4*)(p.out + (size_t)row * D); f32x4 v[8]; float ss = 0.f;
#pragma unroll
        for (int j = 0; j < 8; ++j) { v[j] = xr[64 * j + lane]; ss += (v[j].x * v[j].x + v[j].y * v[j].y) + (v[j].z * v[j].z + v[j].w * v[j].w); }
        const float r = rsqrtf(wave_sum(ss) * (1.f / D) + EPS);
#pragma unroll
        for (int j = 0; j < 8; ++j) xr[64 * j + lane] = v[j] * r * g4[64 * j + lane]; }
}

extern "C" void kernel_launch(void* const* d_in, const int* in_sizes, int n_in, void* d_out, int out_size, void* d_ws, size_t ws_size, hipStream_t stream) {
    static int inited = 0;
    if (!inited) {
        if (n_in != 19 || out_size != S * D || ws_size < WS_END) { fprintf(stderr, "kernel_launch: unexpected shapes n_in %d out %d ws %zu\n", n_in, out_size, ws_size); return; }
        (void)hipFuncSetAttribute((const void*)k_norm_gates, hipFuncAttributeMaxDynamicSharedMemorySize, 65536);
        (void)hipFuncSetAttribute((const void*)k_mlstm_out_naive, hipFuncAttributeMaxDynamicSharedMemorySize, 65536);
        inited = 1;
    }
    Ptrs p{};
    for (int i = 0; i < 19; ++i) p.in[i] = (const float*)d_in[i];
    p.out = (float*)d_out; p.ws = (unsigned char*)d_ws;
    unsigned char* ws = (unsigned char*)d_ws;
    bf16* WIN = (bf16*)(ws + WS_WIN); bf16* XN = (bf16*)(ws + WS_XN); bf16* PROJ = (bf16*)(ws + WS_PROJ);
    bf16* WM = (bf16*)(ws + WS_WM); bf16* WA = (bf16*)(ws + WS_WA); bf16* WO = (bf16*)(ws + WS_WO); bf16* WUP = (bf16*)(ws + WS_WUP); bf16* WDN = (bf16*)(ws + WS_WDN);
    bf16* HM = (bf16*)(ws + WS_HM); bf16* HA = (bf16*)(ws + WS_HA); bf16* MRG = (bf16*)(ws + WS_MRG); bf16* A2 = (bf16*)(ws + WS_A2); bf16* U = (bf16*)(ws + WS_U); bf16* ACT = (bf16*)(ws + WS_ACT);

    hipLaunchKernelGGL(k_transpose, dim3(1024), dim3(256), 0, stream, p);
    hipLaunchKernelGGL(k_norm_gates, dim3(256), dim3(512), 65536, stream, p);
    hipLaunchKernelGGL((k_gemm<EpiStoreBf16, false>), dim3(NP / 128, S / 128), dim3(256), 0, stream, XN, D, WIN, D, nullptr, 0, nullptr, 0, D, EpiStoreBf16{PROJ, NP, 0});
    hipLaunchKernelGGL(k_attn_naive, dim3(4, NCH, AH), dim3(256), 0, stream, p);
    hipLaunchKernelGGL(k_mlstm_local_naive, dim3(NCH, MH), dim3(256), 0, stream, p);
    hipLaunchKernelGGL(k_scan, dim3(256), dim3(512), 0, stream, p);
    hipLaunchKernelGGL(k_mlstm_out_naive, dim3(NCH, MH), dim3(256), 65536, stream, p);
    hipLaunchKernelGGL((k_gemm<EpiMerge, true>), dim3(D / 128, S / 128), dim3(256), 0, stream, HM, 1024, WM, 1024, HA, 1024, WA, 1024, 1024, EpiMerge{PROJ, p.in[9], MRG});
    hipLaunchKernelGGL((k_gemm<EpiResid1, false>), dim3(D / 128, S / 128), dim3(256), 0, stream, MRG, D, WO, D, nullptr, 0, nullptr, 0, D, EpiResid1{p.in[0], p.out, A2, p.in[13]});
    hipLaunchKernelGGL(k_rowstat, dim3(256), dim3(512), 0, stream, p);
    hipLaunchKernelGGL((k_gemm<EpiStoreBf16, false>), dim3(NUP / 128, S / 128), dim3(256), 0, stream, A2, D, WUP, D, nullptr, 0, nullptr, 0, D, EpiStoreBf16{U, NUP, 0});
    hipLaunchKernelGGL(k_ffn_conv, dim3(512), dim3(512), 0, stream, p);
    hipLaunchKernelGGL((k_gemm<EpiResid2, false>), dim3(D / 128, S / 128), dim3(256), 0, stream, ACT, DFF, WDN, DFF, nullptr, 0, nullptr, 0, DFF, EpiResid2{p.out});
    hipLaunchKernelGGL(k_final_norm, dim3(256), dim3(512), 0, stream, p);
}
```

```cpp
#include <hip/hip_runtime.h>
#include <cstdint>
#include <cstdio>
#include <hip/hip_cooperative_groups.h>
namespace cg = cooperative_groups;

typedef unsigned short bf16;
typedef short bf16x8 __attribute__((ext_vector_type(8)));
typedef float f32x4 __attribute__((ext_vector_type(4)));
typedef unsigned u32x4 __attribute__((ext_vector_type(4)));
typedef unsigned u32x2 __attribute__((ext_vector_type(2)));

constexpr int S = 8192, D = 2048, WIN_N = 10248, NP = 10240, DFF = 5632, NUP = 11264;
constexpr int CH = 64, NCH = 128;
constexpr int MH = 4, MDK = 128, MDV = 256, AH = 8, ADH = 128;
constexpr int C_MQ = 0, C_MK = 512, C_MV = 1024, C_MO = 2048, C_AQ = 3072, C_AK = 4096, C_AV = 5120, C_GM = 6144, C_GA = 8192;
constexpr float EPS = 1e-6f, NEGF = -1e30f;

constexpr size_t MiB = 1u << 20;
constexpr size_t WS_WIN = 0;
constexpr size_t WS_XN = 40 * MiB;
constexpr size_t WS_QC = 0;
constexpr size_t WS_KC = 8 * MiB;
constexpr size_t WS_A2 = 0;
constexpr size_t WS_MRG = 32 * MiB;
constexpr size_t WS_ACT = 0;
constexpr size_t WS_WM = 72 * MiB, WS_WA = 76 * MiB, WS_WO = 80 * MiB, WS_WUP = 88 * MiB, WS_WDN = 132 * MiB;
constexpr size_t WS_PROJ = 154 * MiB;
constexpr size_t WS_HM = 314 * MiB, WS_HA = 330 * MiB;
constexpr size_t WS_U = 154 * MiB;
constexpr size_t WS_MISC = 346 * MiB;
constexpr size_t WS_LI = WS_MISC, WS_LF = WS_LI + 131072, WS_MLOC = WS_LF + 131072, WS_BTOT = WS_MLOC + 2048, WS_MPREV = WS_BTOT + 2048,
                 WS_NLOC = WS_MPREV + 2048, WS_NPREV = WS_NLOC + 262144, WS_RS2 = WS_NPREV + 262144, WS_END = WS_RS2 + 32768;
static_assert(WS_END <= 348 * MiB, "ws map");

__device__ __forceinline__ unsigned f2bf(float f) { unsigned u = __builtin_bit_cast(unsigned, f); return (u + 0x7fffu + ((u >> 16) & 1u)) >> 16; }
__device__ __forceinline__ float bf2f(unsigned short b) { return __builtin_bit_cast(float, (unsigned)b << 16); }
__device__ __forceinline__ unsigned pk2(float lo, float hi) { return f2bf(lo) | (f2bf(hi) << 16); }
__device__ __forceinline__ float wave_sum(float v) {
#pragma unroll
    for (int o = 1; o < 64; o <<= 1) v += __shfl_xor(v, o);
    return v;
}
__device__ __forceinline__ float wave_max(float v) {
#pragma unroll
    for (int o = 1; o < 64; o <<= 1) v = fmaxf(v, __shfl_xor(v, o));
    return v;
}
__device__ __forceinline__ float sigmoidf_(float x) { return 1.f / (1.f + __expf(-x)); }

__device__ __forceinline__ int src_col(int mode, int n0) {
    if (mode == 1) return n0 < 3072 ? n0 : n0 + 8;
    if (mode == 2) { const int j = n0 >> 8, i = n0 & 255; return i < 128 ? 128 * j + i : DFF + 128 * j + (i - 128); }
    return n0;
}
__device__ __forceinline__ void transpose_item(const float* W, int K, int Nsrc, int Ndst, bf16* WT, int mode, float* scr, int item, int lane) {
    const int nblk = Ndst / 32, kb = item / nblk, nb = item % nblk, k0 = 64 * kb, n0 = 32 * nb, s0 = src_col(mode, n0);
#pragma unroll 8
    for (int i = 0; i < 32; ++i) { const int kk = 2 * i + (lane >> 5); scr[kk * 33 + (lane & 31)] = W[(size_t)(k0 + kk) * Nsrc + s0 + (lane & 31)]; }
    __builtin_amdgcn_s_waitcnt(0xc07f); asm volatile("" ::: "memory");
    const int c = lane & 7;
#pragma unroll
    for (int j = 0; j < 4; ++j) { const int n = (lane >> 3) + 8 * j; const float* s = scr + (8 * c) * 33 + n;
        u32x4 o; o.x = pk2(s[0 * 33], s[1 * 33]); o.y = pk2(s[2 * 33], s[3 * 33]); o.z = pk2(s[4 * 33], s[5 * 33]); o.w = pk2(s[6 * 33], s[7 * 33]);
        *(u32x4*)(WT + (size_t)(n0 + n) * K + k0 + 8 * c) = o; }
    __builtin_amdgcn_s_waitcnt(0xc07f); asm volatile("" ::: "memory");
}
struct Ptrs {
    const float* in[19]; float* out; unsigned char* ws;
};
constexpr int IT_WIN = (D / 64) * (NP / 32), IT_WM = (1024 / 64) * (D / 32), IT_WO = (D / 64) * (D / 32), IT_WUP = (D / 64) * (NUP / 32), IT_WDN = (DFF / 64) * (D / 32);
constexpr int IT_TOTAL = IT_WIN + 2 * IT_WM + IT_WO + IT_WUP + IT_WDN;


constexpr int NTHR = 512;
constexpr int LDS_BYTES = 147456;

__device__ __forceinline__ void phase_transpose(const Ptrs& p, unsigned char* lds) {
    const int lane = threadIdx.x & 63, wave = threadIdx.x >> 6;
    float* scr = (float*)lds + wave * 64 * 33;
    const int gw = blockIdx.x * 8 + wave, NGW = gridDim.x * 8;
    for (int it = gw; it < IT_TOTAL; it += NGW) {
        int r = it;
        if (r < IT_WIN) { transpose_item(p.in[2], D, WIN_N, NP, (bf16*)(p.ws + WS_WIN), 1, scr, r, lane); continue; } r -= IT_WIN;
        if (r < IT_WM) { transpose_item(p.in[10], 1024, D, D, (bf16*)(p.ws + WS_WM), 0, scr, r, lane); continue; } r -= IT_WM;
        if (r < IT_WM) { transpose_item(p.in[11], 1024, D, D, (bf16*)(p.ws + WS_WA), 0, scr, r, lane); continue; } r -= IT_WM;
        if (r < IT_WO) { transpose_item(p.in[12], D, D, D, (bf16*)(p.ws + WS_WO), 0, scr, r, lane); continue; } r -= IT_WO;
        if (r < IT_WUP) { transpose_item(p.in[14], D, NUP, NUP, (bf16*)(p.ws + WS_WUP), 2, scr, r, lane); continue; } r -= IT_WUP;
        transpose_item(p.in[17], DFF, D, D, (bf16*)(p.ws + WS_WDN), 0, scr, r, lane);
    }
}

__device__ __forceinline__ void phase_norm_gates(const Ptrs& p, unsigned char* lds) {
    float* wgs = (float*)lds;
    const float* w_in = p.in[2];
    for (int i = threadIdx.x; i < 2048 * 8; i += NTHR) wgs[i] = w_in[(size_t)(i >> 3) * WIN_N + 3072 + (i & 7)];
    __syncthreads();
    const int lane = threadIdx.x & 63, wave = threadIdx.x >> 6;
    const int gw = blockIdx.x * 8 + wave, NGW = gridDim.x * 8;
    const float* x = p.in[0]; const f32x4* g4 = (const f32x4*)p.in[1];
    bf16* XN = (bf16*)(p.ws + WS_XN); float* LI = (float*)(p.ws + WS_LI); float* LF = (float*)(p.ws + WS_LF);
    for (int row = gw; row < S; row += NGW) {
        const f32x4* xr = (const f32x4*)(x + (size_t)row * D);
        float ss = 0.f;
#pragma unroll
        for (int j = 0; j < 8; ++j) { const f32x4 v = xr[64 * j + lane]; ss += (v.x * v.x + v.y * v.y) + (v.z * v.z + v.w * v.w); }
        const float r = rsqrtf(wave_sum(ss) * (1.f / D) + EPS);
        float d0 = 0.f, d1 = 0.f, d2 = 0.f, d3 = 0.f, d4 = 0.f, d5 = 0.f, d6 = 0.f, d7 = 0.f;
#pragma unroll 1
        for (int j = 0; j < 8; ++j) {
            const f32x4 g = g4[64 * j + lane]; const f32x4 hv = xr[64 * j + lane] * r * g;
            *(u32x2*)(XN + (size_t)row * D + 4 * (64 * j + lane)) = (u32x2){pk2(hv.x, hv.y), pk2(hv.z, hv.w)};
            const float* w = wgs + (size_t)(4 * (64 * j + lane)) * 8;
#pragma unroll
            for (int e = 0; e < 4; ++e) { const f32x4 w0 = *(const f32x4*)(w + 8 * e), w1 = *(const f32x4*)(w + 8 * e + 4);
                const float hh = e == 0 ? hv.x : e == 1 ? hv.y : e == 2 ? hv.z : hv.w;
                d0 += hh * w0.x; d1 += hh * w0.y; d2 += hh * w0.z; d3 += hh * w0.w;
                d4 += hh * w1.x; d5 += hh * w1.y; d6 += hh * w1.z; d7 += hh * w1.w; }
        }
        float dots[8] = {d0, d1, d2, d3, d4, d5, d6, d7};
#pragma unroll
        for (int q = 0; q < 8; ++q) dots[q] = wave_sum(dots[q]);
        if (lane < 4) { float dv = lane == 0 ? dots[0] : lane == 1 ? dots[1] : lane == 2 ? dots[2] : dots[3]; LI[lane * S + row] = dv + p.in[5][lane]; }
        else if (lane < 8) { const int hh = lane - 4; float dv = hh == 0 ? dots[4] : hh == 1 ? dots[5] : hh == 2 ? dots[6] : dots[7];
            const float z = dv + p.in[6][hh]; const float ee = __expf(-fabsf(z)), uu = 1.f + ee; const float l1p = (uu == 1.f) ? ee : __logf(uu) * (ee / (uu - 1.f)); LF[hh * S + row] = fminf(z, 0.f) - l1p; }
    }
}

template <class Epi, bool DUAL>
__device__ __forceinline__ void phase_gemm_simple(const bf16* A, int lda, const bf16* Bt, int ldb, const bf16* A2, int lda2, const bf16* Bt2, int ldb2, int N, int K, const Epi& epi) {
    const int wave = (threadIdx.x >> 6) & 3, lane = threadIdx.x & 63, fr = lane & 15, fq = lane >> 4;
    const int nbx = N / 128, nvb = nbx * (S / 128);
    for (int vb = 2 * blockIdx.x + (threadIdx.x >> 8); vb < nvb; vb += 2 * gridDim.x) {
        const int bx = vb % nbx, by = vb / nbx;
        const int row0 = by * 128 + (wave >> 1) * 64, col0 = bx * 128 + (wave & 1) * 64;
        f32x4 acc[4][4], acc2[4][4];
#pragma unroll
        for (int i = 0; i < 4; ++i)
#pragma unroll
            for (int j = 0; j < 4; ++j) { acc[i][j] = (f32x4){0.f, 0.f, 0.f, 0.f}; acc2[i][j] = (f32x4){0.f, 0.f, 0.f, 0.f}; }
#pragma unroll 1
        for (int k0 = 0; k0 < K; k0 += 32) {
            bf16x8 a[4], b[4];
#pragma unroll
            for (int i = 0; i < 4; ++i) a[i] = *(const bf16x8*)(A + (size_t)(row0 + 16 * i + fr) * lda + k0 + 8 * fq);
#pragma unroll
            for (int j = 0; j < 4; ++j) b[j] = *(const bf16x8*)(Bt + (size_t)(col0 + 16 * j + fr) * ldb + k0 + 8 * fq);
#pragma unroll
            for (int i = 0; i < 4; ++i)
#pragma unroll
                for (int j = 0; j < 4; ++j) acc[i][j] = __builtin_amdgcn_mfma_f32_16x16x32_bf16(a[i], b[j], acc[i][j], 0, 0, 0);
            if constexpr (DUAL) {
#pragma unroll
                for (int i = 0; i < 4; ++i) a[i] = *(const bf16x8*)(A2 + (size_t)(row0 + 16 * i + fr) * lda2 + k0 + 8 * fq);
#pragma unroll
                for (int j = 0; j < 4; ++j) b[j] = *(const bf16x8*)(Bt2 + (size_t)(col0 + 16 * j + fr) * ldb2 + k0 + 8 * fq);
#pragma unroll
                for (int i = 0; i < 4; ++i)
#pragma unroll
                    for (int j = 0; j < 4; ++j) acc2[i][j] = __builtin_amdgcn_mfma_f32_16x16x32_bf16(a[i], b[j], acc2[i][j], 0, 0, 0);
            }
        }
#pragma unroll
        for (int i = 0; i < 4; ++i)
#pragma unroll
            for (int j = 0; j < 4; ++j)
#pragma unroll
                for (int e = 0; e < 4; ++e) epi(row0 + 16 * i + 4 * fq + e, col0 + 16 * j + fr, acc[i][j][e], acc2[i][j][e]);
    }
}
struct EpiStoreBf16 { bf16* O; int ldc;
    __device__ __forceinline__ void operator()(int r, int c, float v, float) const { O[(size_t)r * ldc + c] = (bf16)f2bf(v); } };
struct EpiMerge { const bf16* P; const float* gb; bf16* O;
    __device__ __forceinline__ void operator()(int r, int c, float ym, float ya) const {
        const float gm = bf2f(P[(size_t)r * NP + C_GM + c]) + gb[c], ga = bf2f(P[(size_t)r * NP + C_GA + c]) + gb[D + c];
        O[(size_t)r * D + c] = (bf16)f2bf(sigmoidf_(gm) * ym + sigmoidf_(ga) * ya); } };
struct EpiResid1 { const float* x; float* out; bf16* A2; const float* g;
    __device__ __forceinline__ void operator()(int r, int c, float v, float) const {
        const float x1 = x[(size_t)r * D + c] + v; out[(size_t)r * D + c] = x1; A2[(size_t)r * D + c] = (bf16)f2bf(x1 * g[c]); } };
struct EpiResid2 { float* out;
    __device__ __forceinline__ void operator()(int r, int c, float v, float) const { out[(size_t)r * D + c] += v; } };

__device__ __forceinline__ void phase_attn_naive(const Ptrs& p, unsigned char* lds) {
    const int half = threadIdx.x >> 8, tid = threadIdx.x & 255, lane = tid & 63, wave = tid >> 6;
    float (*sc)[576] = (float (*)[576])(lds + half * 45056);
    float (*qs)[128] = (float (*)[128])(lds + half * 45056 + 36864);
    const bf16* P = (const bf16*)(p.ws + WS_PROJ); bf16* HA = (bf16*)(p.ws + WS_HA);
    for (int vb = 2 * blockIdx.x + half; vb < 4 * NCH * AH; vb += 2 * gridDim.x) {
        const int qg = vb & 3, c = (vb >> 2) & 127, h = vb >> 9;
        const float* bias = p.in[8] + h * 257;
        const int t0 = c * 64 + qg * 16;
        { const int row = tid >> 4, d0 = (tid & 15) * 8; const bf16x8 q = *(const bf16x8*)(P + (size_t)(t0 + row) * NP + C_AQ + h * 128 + d0);
#pragma unroll
          for (int e = 0; e < 8; ++e) qs[row][d0 + e] = bf2f((unsigned short)q[e]); }
        __syncthreads();
        for (int kk = tid; kk < 576; kk += 256) {
            const int kpos = (c - 8) * 64 + kk;
            float acc[16];
#pragma unroll
            for (int i = 0; i < 16; ++i) acc[i] = 0.f;
            if (kpos >= 0) {
                const bf16* kr = P + (size_t)kpos * NP + C_AK + h * 128;
#pragma unroll 1
                for (int d0 = 0; d0 < 16; ++d0) { const bf16x8 kv = *(const bf16x8*)(kr + d0 * 8); float kf[8];
#pragma unroll
                    for (int e = 0; e < 8; ++e) kf[e] = bf2f((unsigned short)kv[e]);
#pragma unroll
                    for (int i = 0; i < 16; ++i)
#pragma unroll
                        for (int e = 0; e < 8; ++e) acc[i] += qs[i][d0 * 8 + e] * kf[e]; }
            }
#pragma unroll
            for (int i = 0; i < 16; ++i) {
                float s = NEGF;
                if (kpos >= 0) { int rel = (512 + qg * 16 + i) - kk; rel = rel < -128 ? -128 : (rel > 128 ? 128 : rel); s = acc[i] * 0.08838834764831845f + bias[rel + 128]; }
                sc[i][kk] = s; }
        }
        __syncthreads();
        for (int rr = 0; rr < 4; ++rr) { const int row = wave * 4 + rr; float m = NEGF;
            for (int i = 0; i < 9; ++i) m = fmaxf(m, sc[row][lane + 64 * i]);
            m = wave_max(m); float sum = 0.f;
            for (int i = 0; i < 9; ++i) { const float e = __expf(sc[row][lane + 64 * i] - m); sc[row][lane + 64 * i] = e; sum += e; }
            sum = wave_sum(sum); const float inv = 1.f / sum;
            for (int i = 0; i < 9; ++i) sc[row][lane + 64 * i] *= inv; }
        __syncthreads();
        { const int d = tid & 127, hf = tid >> 7; float acc[8];
#pragma unroll
          for (int i = 0; i < 8; ++i) acc[i] = 0.f;
#pragma unroll 1
          for (int kk = 0; kk < 576; ++kk) { const int kpos = (c - 8) * 64 + kk; if (kpos < 0) continue;
              const float v = bf2f(P[(size_t)kpos * NP + C_AV + h * 128 + d]);
#pragma unroll
              for (int i = 0; i < 8; ++i) acc[i] += sc[hf * 8 + i][kk] * v; }
#pragma unroll
          for (int i = 0; i < 8; ++i) HA[(size_t)(t0 + hf * 8 + i) * 1024 + h * 128 + d] = (bf16)f2bf(acc[i]); }
        __syncthreads();
    }
}

__device__ __forceinline__ void phase_mlstm_local_naive(const Ptrs& p, unsigned char* lds) {
    const int half = threadIdx.x >> 8, tid = threadIdx.x & 255;
    float (*ks)[128] = (float (*)[128])(lds + half * 33792);
    float* bsh = (float*)(lds + half * 33792 + 32768); float* wsh = bsh + 64;
    const bf16* P = (const bf16*)(p.ws + WS_PROJ); bf16* QC = (bf16*)(p.ws + WS_QC); bf16* KC = (bf16*)(p.ws + WS_KC);
    const float* cw = p.in[3]; const float* cb = p.in[4];
    const float* LI = (const float*)(p.ws + WS_LI); const float* LF = (const float*)(p.ws + WS_LF);
    for (int vb = 2 * blockIdx.x + half; vb < NCH * MH; vb += 2 * gridDim.x) {
        const int c = vb & 127, h = vb >> 7, t0 = c * 64;
        for (int idx = tid; idx < 2 * 64 * 128; idx += 256) {
            const int which = idx >> 13, rem = idx & 8191, t = rem >> 7, ch = rem & 127, gch = which * 512 + h * 128 + ch;
            float a = cb[gch];
#pragma unroll
            for (int tap = 0; tap < 4; ++tap) { const int tt = t0 + t - 3 + tap; if (tt >= 0) a += cw[tap * 1024 + gch] * bf2f(P[(size_t)tt * NP + gch]); }
            float y = a * sigmoidf_(a);
            if (which == 0) QC[(size_t)(t0 + t) * 512 + h * 128 + ch] = (bf16)f2bf(y);
            else { y *= 0.08838834764831845f; const unsigned short b = (unsigned short)f2bf(y); KC[(size_t)(t0 + t) * 512 + h * 128 + ch] = b; ks[t][ch] = bf2f(b); }
        }
        if (tid == 0) {
            float run = 0.f;
            for (int s = 0; s < 64; ++s) { run += LF[h * S + t0 + s]; bsh[s] = run; }
            const float btot = run; float m = -INFINITY;
            for (int s = 0; s < 64; ++s) { const float wl = btot - bsh[s] + LI[h * S + t0 + s]; wsh[s] = wl; m = fmaxf(m, wl); }
            for (int s = 0; s < 64; ++s) wsh[s] = __expf(wsh[s] - m);
            ((float*)(p.ws + WS_MLOC))[h * 128 + c] = m; ((float*)(p.ws + WS_BTOT))[h * 128 + c] = btot;
        }
        __syncthreads();
        { const int dv = tid; float vw[64];
#pragma unroll
          for (int s = 0; s < 64; ++s) vw[s] = bf2f(P[(size_t)(t0 + s) * NP + C_MV + h * 256 + dv]) * wsh[s];
          float* CL = p.out + ((size_t)(h * 128 + c) * 256 + dv) * 128;
#pragma unroll 1
          for (int dk = 0; dk < 128; ++dk) { float sum = 0.f;
#pragma unroll
              for (int s = 0; s < 64; ++s) sum += vw[s] * ks[s][dk];
              CL[dk] = sum; } }
        if (tid < 128) { float sum = 0.f; for (int s = 0; s < 64; ++s) sum += wsh[s] * ks[s][tid]; ((float*)(p.ws + WS_NLOC))[(h * 128 + c) * 128 + tid] = sum; }
        __syncthreads();
    }
}

__device__ __forceinline__ void phase_scan(const Ptrs& p) {
    float* CL = p.out; const float* MLOC = (const float*)(p.ws + WS_MLOC); const float* BTOT = (const float*)(p.ws + WS_BTOT);
    float* MPREV = (float*)(p.ws + WS_MPREV); const float* NLOC = (const float*)(p.ws + WS_NLOC); float* NPREV = (float*)(p.ws + WS_NPREV);
    const int tid = threadIdx.x;
    for (int vb = blockIdx.x; vb < 256; vb += gridDim.x) {
        const int h = vb >> 6, rest = ((vb & 63) << 9) + tid;
        const bool nthr = ((vb & 63) == 0) && tid < 128, mthr = ((vb & 63) == 0) && tid == 0;
        float m = NEGF, st = 0.f, nst = 0.f;
#pragma unroll 1
        for (int c0 = 0; c0 < NCH; c0 += 8) {
            float val[8], nv[8];
#pragma unroll
            for (int i = 0; i < 8; ++i) { val[i] = CL[((size_t)(h * 128 + c0 + i) << 15) + rest]; nv[i] = nthr ? NLOC[(h * 128 + c0 + i) * 128 + tid] : 0.f; }
#pragma unroll
            for (int i = 0; i < 8; ++i) { const int c = c0 + i;
                const float bt = BTOT[h * 128 + c], ml = MLOC[h * 128 + c];
                CL[((size_t)(h * 128 + c) << 15) + rest] = st;
                if (nthr) NPREV[(h * 128 + c) * 128 + tid] = nst;
                if (mthr) MPREV[h * 128 + c] = m;
                const float mn = fmaxf(bt + m, ml), a = __expf(bt + m - mn), cl = __expf(ml - mn);
                st = a * st + cl * val[i]; nst = a * nst + cl * nv[i]; m = mn; }
        }
    }
}

__device__ __forceinline__ void phase_mlstm_out_naive(const Ptrs& p, unsigned char* lds0) {
    const int half = threadIdx.x >> 8, tid = threadIdx.x & 255, lane = tid & 63, wave = tid >> 6;
    unsigned char* lds = lds0 + half * 51200;
    float (*qs)[128] = (float (*)[128])lds;
    float (*ps)[64] = (float (*)[64])(lds + 32768);
    float* bsh = (float*)(lds + 49152); float* lish = bsh + 64; float* ash = lish + 64; float* dsh = ash + 64; float* red = dsh + 64;
    const bf16* P = (const bf16*)(p.ws + WS_PROJ); const bf16* QC = (const bf16*)(p.ws + WS_QC); const bf16* KC = (const bf16*)(p.ws + WS_KC);
    const float* LI = (const float*)(p.ws + WS_LI); const float* LF = (const float*)(p.ws + WS_LF);
    bf16* HM = (bf16*)(p.ws + WS_HM);
    for (int vb = 2 * blockIdx.x + half; vb < NCH * MH; vb += 2 * gridDim.x) {
        const int c = vb & 127, h = vb >> 7, t0 = c * 64;
        for (int i = tid; i < 64 * 16; i += 256) { const int t = i >> 4, d0 = (i & 15) * 8; const bf16x8 q = *(const bf16x8*)(QC + (size_t)(t0 + t) * 512 + h * 128 + d0);
#pragma unroll
            for (int e = 0; e < 8; ++e) qs[t][d0 + e] = bf2f((unsigned short)q[e]); }
        if (tid == 0) { float run = 0.f; for (int s = 0; s < 64; ++s) { run += LF[h * S + t0 + s]; bsh[s] = run; lish[s] = LI[h * S + t0 + s]; } }
        __syncthreads();
        const float mprev = ((const float*)(p.ws + WS_MPREV))[h * 128 + c];
        { const int t = tid >> 2, sg = tid & 3; float dot[16]; float mt = bsh[t] + mprev;
#pragma unroll
          for (int si = 0; si < 16; ++si) { const int s = sg * 16 + si; float a = 0.f; const bf16* kr = KC + (size_t)(t0 + s) * 512 + h * 128;
#pragma unroll 1
              for (int d0 = 0; d0 < 16; ++d0) { const bf16x8 kv = *(const bf16x8*)(kr + d0 * 8);
#pragma unroll
                  for (int e = 0; e < 8; ++e) a += qs[t][d0 * 8 + e] * bf2f((unsigned short)kv[e]); }
              dot[si] = a; if (s <= t) mt = fmaxf(mt, bsh[t] - bsh[s] + lish[s]); }
          mt = fmaxf(mt, __shfl_xor(mt, 1)); mt = fmaxf(mt, __shfl_xor(mt, 2));
          float psum = 0.f;
#pragma unroll
          for (int si = 0; si < 16; ++si) { const int s = sg * 16 + si; const float pv = (s <= t) ? __expf(bsh[t] - bsh[s] + lish[s] - mt) * dot[si] : 0.f; ps[t][s] = pv; psum += pv; }
          psum += __shfl_xor(psum, 1); psum += __shfl_xor(psum, 2);
          const float* np = (const float*)(p.ws + WS_NPREV) + (h * 128 + c) * 128; float qn = 0.f;
          for (int dk = sg * 32; dk < sg * 32 + 32; ++dk) qn += qs[t][dk] * np[dk];
          qn += __shfl_xor(qn, 1); qn += __shfl_xor(qn, 2);
          const float ai = __expf(bsh[t] + mprev - mt), den = psum + ai * qn;
          if (sg == 0) { ash[t] = ai; dsh[t] = fmaxf(fabsf(den), __expf(-mt)); } }
        __syncthreads();
        const int dv = tid;
        const float mn = p.in[7][h * 256 + dv];
        const float* cp = p.out + ((size_t)(h * 128 + c) * 256 + dv) * 128;
#pragma unroll 1
        for (int th = 0; th < 4; ++th) {
            float ainter[16], aintra[16];
#pragma unroll
            for (int t = 0; t < 16; ++t) { ainter[t] = 0.f; aintra[t] = 0.f; }
#pragma unroll 1
            for (int dk0 = 0; dk0 < 128; dk0 += 4) { const f32x4 c4 = *(const f32x4*)(cp + dk0);
#pragma unroll
                for (int t = 0; t < 16; ++t) { const f32x4 q4 = *(const f32x4*)(&qs[th * 16 + t][dk0]); ainter[t] += (q4.x * c4.x + q4.y * c4.y) + (q4.z * c4.z + q4.w * c4.w); } }
#pragma unroll 1
            for (int s0 = 0; s0 < 64; s0 += 4) { float vv[4];
#pragma unroll
                for (int e = 0; e < 4; ++e) vv[e] = bf2f(P[(size_t)(t0 + s0 + e) * NP + C_MV + h * 256 + dv]);
#pragma unroll
                for (int t = 0; t < 16; ++t) { const f32x4 p4 = *(const f32x4*)(&ps[th * 16 + t][s0]); aintra[t] += (p4.x * vv[0] + p4.y * vv[1]) + (p4.z * vv[2] + p4.w * vv[3]); } }
            float hv[16];
#pragma unroll
            for (int t = 0; t < 16; ++t) { hv[t] = (aintra[t] + ash[th * 16 + t] * ainter[t]) / dsh[th * 16 + t]; const float ss = wave_sum(hv[t] * hv[t]); if (lane == 0) red[wave * 64 + th * 16 + t] = ss; }
            __syncthreads();
#pragma unroll
            for (int t = 0; t < 16; ++t) { const int tt = th * 16 + t; const float ss = (red[tt] + red[64 + tt]) + (red[128 + tt] + red[192 + tt]); const float r = rsqrtf(ss * (1.f / 256.f) + EPS);
                const float o = bf2f(P[(size_t)(t0 + tt) * NP + C_MO + h * 256 + dv]);
                HM[(size_t)(t0 + tt) * 1024 + h * 256 + dv] = (bf16)f2bf(hv[t] * r * mn * sigmoidf_(o)); }
        }
        __syncthreads();
    }
}

__device__ __forceinline__ void phase_rowstat(const Ptrs& p) {
    const int lane = threadIdx.x & 63, gw = blockIdx.x * 8 + (threadIdx.x >> 6), NGW = gridDim.x * 8;
    float* RS2 = (float*)(p.ws + WS_RS2);
    for (int row = gw; row < S; row += NGW) { const f32x4* xr = (const f32x4*)(p.out + (size_t)row * D); float ss = 0.f;
#pragma unroll
        for (int j = 0; j < 8; ++j) { const f32x4 v = xr[64 * j + lane]; ss += (v.x * v.x + v.y * v.y) + (v.z * v.z + v.w * v.w); }
        ss = wave_sum(ss); if (lane == 0) RS2[row] = rsqrtf(ss * (1.f / D) + EPS); }
}

__device__ __forceinline__ void phase_ffn_conv(const Ptrs& p) {
    const int lane = threadIdx.x & 63, gw = blockIdx.x * 8 + (threadIdx.x >> 6), NGW = gridDim.x * 8;
    const bf16* U = (const bf16*)(p.ws + WS_U); bf16* ACT = (bf16*)(p.ws + WS_ACT); const float* RS2 = (const float*)(p.ws + WS_RS2);
    const float* cw = p.in[15]; const float* cb = p.in[16];
    constexpr int NCB = DFF / 512, NRB = S / 16;
    for (int unit = gw; unit < NCB * NRB; unit += NGW) {
        const int cbk = unit % NCB, rb = unit / NCB, ch0 = cbk * 512 + lane * 8, j = ch0 >> 7, i0 = ch0 & 127, gcol = 256 * j + i0, vcol = gcol + 128, r0 = rb * 16;
        float w0[8], w1[8], w2[8], bb[8], gm2[8], gm1[8];
#pragma unroll
        for (int e = 0; e < 8; ++e) { w0[e] = cw[ch0 + e]; w1[e] = cw[DFF + ch0 + e]; w2[e] = cw[2 * DFF + ch0 + e]; bb[e] = cb[ch0 + e]; gm2[e] = 0.f; gm1[e] = 0.f; }
        if (r0 >= 2) { const float ra = RS2[r0 - 2], rbv = RS2[r0 - 1];
            const bf16x8 a = *(const bf16x8*)(U + (size_t)(r0 - 2) * NUP + gcol), b = *(const bf16x8*)(U + (size_t)(r0 - 1) * NUP + gcol);
#pragma unroll
            for (int e = 0; e < 8; ++e) { gm2[e] = ra * bf2f((unsigned short)a[e]); gm1[e] = rbv * bf2f((unsigned short)b[e]); } }
#pragma unroll 1
        for (int t = r0; t < r0 + 16; ++t) { const float r = RS2[t];
            const bf16x8 g = *(const bf16x8*)(U + (size_t)t * NUP + gcol), v = *(const bf16x8*)(U + (size_t)t * NUP + vcol); float o[8];
#pragma unroll
            for (int e = 0; e < 8; ++e) { const float g0 = r * bf2f((unsigned short)g[e]); const float cv = bb[e] + w0[e] * gm2[e] + w1[e] * gm1[e] + w2[e] * g0;
                o[e] = cv * sigmoidf_(cv) * (r * bf2f((unsigned short)v[e])); gm2[e] = gm1[e]; gm1[e] = g0; }
            *(u32x4*)(ACT + (size_t)t * DFF + ch0) = (u32x4){pk2(o[0], o[1]), pk2(o[2], o[3]), pk2(o[4], o[5]), pk2(o[6], o[7])}; }
    }
}

__device__ __forceinline__ void phase_final_norm(const Ptrs& p) {
    const int lane = threadIdx.x & 63, gw = blockIdx.x * 8 + (threadIdx.x >> 6), NGW = gridDim.x * 8;
    const f32x4* g4 = (const f32x4*)p.in[18];
    for (int row = gw; row < S; row += NGW) { f32x4* xr = (f32x4*)(p.out + (size_t)row * D); f32x4 v[8]; float ss = 0.f;
#pragma unroll
        for (int j = 0; j < 8; ++j) { v[j] = xr[64 * j + lane]; ss += (v[j].x * v[j].x + v[j].y * v[j].y) + (v[j].z * v[j].z + v[j].w * v[j].w); }
        const float r = rsqrtf(wave_sum(ss) * (1.f / D) + EPS);
#pragma unroll
        for (int j = 0; j < 8; ++j) xr[64 * j + lane] = v[j] * r * g4[64 * j + lane]; }
}

__global__ void __launch_bounds__(NTHR) mega(Ptrs p) {
    extern __shared__ __attribute__((aligned(16))) unsigned char lds[];
    cg::grid_group grid = cg::this_grid();
    unsigned char* ws = p.ws;
    bf16* WIN = (bf16*)(ws + WS_WIN); bf16* XN = (bf16*)(ws + WS_XN); bf16* PROJ = (bf16*)(ws + WS_PROJ);
    bf16* WM = (bf16*)(ws + WS_WM); bf16* WA = (bf16*)(ws + WS_WA); bf16* WO = (bf16*)(ws + WS_WO); bf16* WUP = (bf16*)(ws + WS_WUP); bf16* WDN = (bf16*)(ws + WS_WDN);
    bf16* HM = (bf16*)(ws + WS_HM); bf16* HA = (bf16*)(ws + WS_HA); bf16* MRG = (bf16*)(ws + WS_MRG); bf16* A2 = (bf16*)(ws + WS_A2); bf16* U = (bf16*)(ws + WS_U); bf16* ACT = (bf16*)(ws + WS_ACT);
    phase_transpose(p, lds);
    __syncthreads();
    phase_norm_gates(p, lds);
    grid.sync();
    phase_gemm_simple<EpiStoreBf16, false>(XN, D, WIN, D, nullptr, 0, nullptr, 0, NP, D, EpiStoreBf16{PROJ, NP});
    grid.sync();
    phase_attn_naive(p, lds);
    __syncthreads();
    phase_mlstm_local_naive(p, lds);
    grid.sync();
    phase_scan(p);
    grid.sync();
    phase_mlstm_out_naive(p, lds);
    grid.sync();
    phase_gemm_simple<EpiMerge, true>(HM, 1024, WM, 1024, HA, 1024, WA, 1024, D, 1024, EpiMerge{PROJ, p.in[9], MRG});
    grid.sync();
    phase_gemm_simple<EpiResid1, false>(MRG, D, WO, D, nullptr, 0, nullptr, 0, D, D, EpiResid1{p.in[0], p.out, A2, p.in[13]});
    grid.sync();
    phase_rowstat(p);
    phase_gemm_simple<EpiStoreBf16, false>(A2, D, WUP, D, nullptr, 0, nullptr, 0, NUP, D, EpiStoreBf16{U, NUP});
    grid.sync();
    phase_ffn_conv(p);
    grid.sync();
    phase_gemm_simple<EpiResid2, false>(ACT, DFF, WDN, DFF, nullptr, 0, nullptr, 0, D, DFF, EpiResid2{p.out});
    grid.sync();
    phase_final_norm(p);
}

extern "C" void kernel_launch(void* const* d_in, const int* in_sizes, int n_in, void* d_out, int out_size, void* d_ws, size_t ws_size, hipStream_t stream) {
    static int grid_blocks = 0;
    if (grid_blocks == 0) {
        if (n_in != 19 || out_size != S * D || ws_size < WS_END) { fprintf(stderr, "kernel_launch: unexpected shapes n_in %d out %d ws %zu\n", n_in, out_size, ws_size); grid_blocks = -1; return; }
        int dev = 0, cus = 0, per_cu = 0;
        (void)hipGetDevice(&dev);
        (void)hipDeviceGetAttribute(&cus, hipDeviceAttributeMultiprocessorCount, dev);
        (void)hipFuncSetAttribute((const void*)mega, hipFuncAttributeMaxDynamicSharedMemorySize, LDS_BYTES);
        (void)hipOccupancyMaxActiveBlocksPerMultiprocessor(&per_cu, (const void*)mega, NTHR, LDS_BYTES);
        if (per_cu < 1) { fprintf(stderr, "kernel_launch: occupancy query returned %d\n", per_cu); per_cu = 1; }
        if (per_cu > 1) per_cu = 1;
        grid_blocks = cus * per_cu;
        fprintf(stderr, "kernel_launch: cus %d per_cu %d grid %d\n", cus, per_cu, grid_blocks);
    }
    if (grid_blocks < 0) return;
    Ptrs p{};
    for (int i = 0; i < 19; ++i) p.in[i] = (const float*)d_in[i];
    p.out = (float*)d_out; p.ws = (unsigned char*)d_ws;
    void* args[] = {&p};
    hipError_t e = hipLaunchCooperativeKernel((const void*)mega, dim3(grid_blocks), dim3(NTHR), args, LDS_BYTES, stream);
    if (e != hipSuccess) fprintf(stderr, "cooperative launch failed: %s (grid %d)\n", hipGetErrorString(e), grid_blocks);
}
```

```cpp
#include <hip/hip_runtime.h>
#include <cstdint>
#include <cstdio>
#include <hip/hip_cooperative_groups.h>
namespace cg = cooperative_groups;

typedef unsigned short bf16;
typedef short bf16x8 __attribute__((ext_vector_type(8)));
typedef float f32x4 __attribute__((ext_vector_type(4)));
typedef unsigned u32x4 __attribute__((ext_vector_type(4)));
typedef unsigned u32x2 __attribute__((ext_vector_type(2)));

constexpr int S = 8192, D = 2048, WIN_N = 10248, NP = 10240, DFF = 5632, NUP = 11264;
constexpr int CH = 64, NCH = 128;
constexpr int MH = 4, MDK = 128, MDV = 256, AH = 8, ADH = 128;
constexpr int C_MQ = 0, C_MK = 512, C_MV = 1024, C_MO = 2048, C_AQ = 3072, C_AK = 4096, C_AV = 5120, C_GM = 6144, C_GA = 8192;
constexpr float EPS = 1e-6f, NEGF = -1e30f;

constexpr size_t MiB = 1u << 20;
constexpr size_t WS_WIN = 0;
constexpr size_t WS_XN = 40 * MiB;
constexpr size_t WS_QC = 0;
constexpr size_t WS_KC = 8 * MiB;
constexpr size_t WS_A2 = 0;
constexpr size_t WS_MRG = 32 * MiB;
constexpr size_t WS_ACT = 0;
constexpr size_t WS_WM = 72 * MiB, WS_WA = 76 * MiB, WS_WO = 80 * MiB, WS_WUP = 88 * MiB, WS_WDN = 132 * MiB;
constexpr size_t WS_PROJ = 154 * MiB;
constexpr size_t WS_HM = 314 * MiB, WS_HA = 330 * MiB;
constexpr size_t WS_U = 154 * MiB;
constexpr size_t WS_MISC = 346 * MiB;
constexpr size_t WS_LI = WS_MISC, WS_LF = WS_LI + 131072, WS_MLOC = WS_LF + 131072, WS_BTOT = WS_MLOC + 2048, WS_MPREV = WS_BTOT + 2048,
                 WS_NLOC = WS_MPREV + 2048, WS_NPREV = WS_NLOC + 262144, WS_RS2 = WS_NPREV + 262144, WS_SLAB = WS_RS2 + 32768, WS_END = WS_SLAB + 32 * 8192 * 4;
static_assert(WS_END <= 348 * MiB, "ws map");

__device__ __forceinline__ unsigned f2bf(float f) { unsigned u = __builtin_bit_cast(unsigned, f); return (u + 0x7fffu + ((u >> 16) & 1u)) >> 16; }
__device__ __forceinline__ float bf2f(unsigned short b) { return __builtin_bit_cast(float, (unsigned)b << 16); }
__device__ __forceinline__ unsigned pk2(float lo, float hi) { return f2bf(lo) | (f2bf(hi) << 16); }
__device__ __forceinline__ float wave_sum(float v) {
#pragma unroll
    for (int o = 1; o < 64; o <<= 1) v += __shfl_xor(v, o);
    return v;
}
__device__ __forceinline__ float wave_max(float v) {
#pragma unroll
    for (int o = 1; o < 64; o <<= 1) v = fmaxf(v, __shfl_xor(v, o));
    return v;
}
__device__ __forceinline__ int lane_id() { int r; asm volatile("v_mbcnt_lo_u32_b32 %0, -1, 0\n\tv_mbcnt_hi_u32_b32 %0, -1, %0" : "=v"(r)); return r; }
__device__ __forceinline__ float sigmoidf_(float x) { return 1.f / (1.f + __expf(-x)); }

__device__ __forceinline__ int src_col(int mode, int n0) {
    if (mode == 1) return n0 < 3072 ? n0 : n0 + 8;
    if (mode == 2) { const int j = n0 >> 8, i = n0 & 255; return i < 128 ? 128 * j + i : DFF + 128 * j + (i - 128); }
    return n0;
}
__device__ __forceinline__ void transpose_item(const float* W, int K, int Nsrc, int Ndst, bf16* WT, int mode, float* scr, int item, int lane) {
    const int nblk = Ndst / 32, kb = item / nblk, nb = item % nblk, k0 = 64 * kb, n0 = 32 * nb, s0 = src_col(mode, n0);
#pragma unroll 8
    for (int i = 0; i < 32; ++i) { const int kk = 2 * i + (lane >> 5); scr[kk * 33 + (lane & 31)] = W[(size_t)(k0 + kk) * Nsrc + s0 + (lane & 31)]; }
    __builtin_amdgcn_s_waitcnt(0xc07f); asm volatile("" ::: "memory");
    const int c = lane & 7;
#pragma unroll
    for (int j = 0; j < 4; ++j) { const int n = (lane >> 3) + 8 * j; const float* s = scr + (8 * c) * 33 + n;
        u32x4 o; o.x = pk2(s[0 * 33], s[1 * 33]); o.y = pk2(s[2 * 33], s[3 * 33]); o.z = pk2(s[4 * 33], s[5 * 33]); o.w = pk2(s[6 * 33], s[7 * 33]);
        *(u32x4*)(WT + (size_t)(n0 + n) * K + k0 + 8 * c) = o; }
    __builtin_amdgcn_s_waitcnt(0xc07f); asm volatile("" ::: "memory");
}
struct Ptrs {
    const float* in[19]; float* out; unsigned char* ws;
};
constexpr int IT_WIN = (D / 64) * (NP / 32), IT_WM = (1024 / 64) * (D / 32), IT_WO = (D / 64) * (D / 32), IT_WUP = (D / 64) * (NUP / 32), IT_WDN = (DFF / 64) * (D / 32);
constexpr int IT_TOTAL = IT_WIN + 2 * IT_WM + IT_WO + IT_WUP + IT_WDN;


constexpr int NTHR = 512;
constexpr int LDS_BYTES = 147456;

__device__ __forceinline__ void phase_transpose(const Ptrs& p, unsigned char* lds, int wid_) {
    const int TIDX = wid_ * 64 + lane_id();
    const int lane = TIDX & 63, wave = TIDX >> 6;
    float* scr = (float*)lds + wave * 64 * 33;
    const int gw = blockIdx.x * 8 + wave, NGW = gridDim.x * 8;
    for (int it = gw; it < IT_TOTAL; it += NGW) {
        int r = it;
        if (r < IT_WIN) { transpose_item(p.in[2], D, WIN_N, NP, (bf16*)(p.ws + WS_WIN), 1, scr, r, lane); continue; } r -= IT_WIN;
        if (r < IT_WM) { transpose_item(p.in[10], 1024, D, D, (bf16*)(p.ws + WS_WM), 0, scr, r, lane); continue; } r -= IT_WM;
        if (r < IT_WM) { transpose_item(p.in[11], 1024, D, D, (bf16*)(p.ws + WS_WA), 0, scr, r, lane); continue; } r -= IT_WM;
        if (r < IT_WO) { transpose_item(p.in[12], D, D, D, (bf16*)(p.ws + WS_WO), 0, scr, r, lane); continue; } r -= IT_WO;
        if (r < IT_WUP) { transpose_item(p.in[14], D, NUP, NUP, (bf16*)(p.ws + WS_WUP), 2, scr, r, lane); continue; } r -= IT_WUP;
        transpose_item(p.in[17], DFF, D, D, (bf16*)(p.ws + WS_WDN), 0, scr, r, lane);
    }
}

__device__ __forceinline__ void phase_norm_gates(const Ptrs& p, unsigned char* lds, int wid_) {
    const int TIDX = wid_ * 64 + lane_id();
    float* wgs = (float*)lds;
    const float* w_in = p.in[2];
    for (int i = TIDX; i < 2048 * 8; i += NTHR) wgs[i] = w_in[(size_t)(i >> 3) * WIN_N + 3072 + (i & 7)];
    __syncthreads();
    const int lane = TIDX & 63, wave = TIDX >> 6;
    const int gw = blockIdx.x * 8 + wave, NGW = gridDim.x * 8;
    const float* x = p.in[0]; const f32x4* g4 = (const f32x4*)p.in[1];
    bf16* XN = (bf16*)(p.ws + WS_XN); float* LI = (float*)(p.ws + WS_LI); float* LF = (float*)(p.ws + WS_LF);
    for (int row = gw; row < S; row += NGW) {
        const f32x4* xr = (const f32x4*)(x + (size_t)row * D);
        float ss = 0.f;
#pragma unroll
        for (int j = 0; j < 8; ++j) { const f32x4 v = xr[64 * j + lane]; ss += (v.x * v.x + v.y * v.y) + (v.z * v.z + v.w * v.w); }
        const float r = rsqrtf(wave_sum(ss) * (1.f / D) + EPS);
        float d0 = 0.f, d1 = 0.f, d2 = 0.f, d3 = 0.f, d4 = 0.f, d5 = 0.f, d6 = 0.f, d7 = 0.f;
#pragma unroll 1
        for (int j = 0; j < 8; ++j) {
            const f32x4 g = g4[64 * j + lane]; const f32x4 hv = xr[64 * j + lane] * r * g;
            *(u32x2*)(XN + (size_t)row * D + 4 * (64 * j + lane)) = (u32x2){pk2(hv.x, hv.y), pk2(hv.z, hv.w)};
            const float* w = wgs + (size_t)(4 * (64 * j + lane)) * 8;
#pragma unroll
            for (int e = 0; e < 4; ++e) { const f32x4 w0 = *(const f32x4*)(w + 8 * e), w1 = *(const f32x4*)(w + 8 * e + 4);
                const float hh = e == 0 ? hv.x : e == 1 ? hv.y : e == 2 ? hv.z : hv.w;
                d0 += hh * w0.x; d1 += hh * w0.y; d2 += hh * w0.z; d3 += hh * w0.w;
                d4 += hh * w1.x; d5 += hh * w1.y; d6 += hh * w1.z; d7 += hh * w1.w; }
        }
        float dots[8] = {d0, d1, d2, d3, d4, d5, d6, d7};
#pragma unroll
        for (int q = 0; q < 8; ++q) dots[q] = wave_sum(dots[q]);
        if (lane < 4) { float dv = lane == 0 ? dots[0] : lane == 1 ? dots[1] : lane == 2 ? dots[2] : dots[3]; LI[lane * S + row] = dv + p.in[5][lane]; }
        else if (lane < 8) { const int hh = lane - 4; float dv = hh == 0 ? dots[4] : hh == 1 ? dots[5] : hh == 2 ? dots[6] : dots[7];
            const float z = dv + p.in[6][hh]; const float ee = __expf(-fabsf(z)), uu = 1.f + ee; const float l1p = (uu == 1.f) ? ee : __logf(uu) * (ee / (uu - 1.f)); LF[hh * S + row] = fminf(z, 0.f) - l1p; }
    }
}

__device__ __forceinline__ void phase_attn_naive(const Ptrs& p, unsigned char* lds, int wid_) {
    const int TIDX = wid_ * 64 + lane_id();
    const int half = TIDX >> 8, tid = TIDX & 255, lane = tid & 63, wave = tid >> 6;
    float (*sc)[576] = (float (*)[576])(lds + half * 45056);
    float (*qs)[128] = (float (*)[128])(lds + half * 45056 + 36864);
    const bf16* P = (const bf16*)(p.ws + WS_PROJ); bf16* HA = (bf16*)(p.ws + WS_HA);
    for (int vb = 2 * blockIdx.x + half; vb < 4 * NCH * AH; vb += 2 * gridDim.x) {
        const int qg = vb & 3, c = (vb >> 2) & 127, h = vb >> 9;
        const float* bias = p.in[8] + h * 257;
        const int t0 = c * 64 + qg * 16;
        { const int row = tid >> 4, d0 = (tid & 15) * 8; const bf16x8 q = *(const bf16x8*)(P + (size_t)(t0 + row) * NP + C_AQ + h * 128 + d0);
#pragma unroll
          for (int e = 0; e < 8; ++e) qs[row][d0 + e] = bf2f((unsigned short)q[e]); }
        __syncthreads();
        for (int kk = tid; kk < 576; kk += 256) {
            const int kpos = (c - 8) * 64 + kk;
            float acc[16];
#pragma unroll
            for (int i = 0; i < 16; ++i) acc[i] = 0.f;
            if (kpos >= 0) {
                const bf16* kr = P + (size_t)kpos * NP + C_AK + h * 128;
#pragma unroll 1
                for (int d0 = 0; d0 < 16; ++d0) { const bf16x8 kv = *(const bf16x8*)(kr + d0 * 8); float kf[8];
#pragma unroll
                    for (int e = 0; e < 8; ++e) kf[e] = bf2f((unsigned short)kv[e]);
#pragma unroll
                    for (int i = 0; i < 16; ++i)
#pragma unroll
                        for (int e = 0; e < 8; ++e) acc[i] += qs[i][d0 * 8 + e] * kf[e]; }
            }
#pragma unroll
            for (int i = 0; i < 16; ++i) {
                float s = NEGF;
                if (kpos >= 0) { int rel = (512 + qg * 16 + i) - kk; rel = rel < -128 ? -128 : (rel > 128 ? 128 : rel); s = acc[i] * 0.08838834764831845f + bias[rel + 128]; }
                sc[i][kk] = s; }
        }
        __syncthreads();
        for (int rr = 0; rr < 4; ++rr) { const int row = wave * 4 + rr; float m = NEGF;
            for (int i = 0; i < 9; ++i) m = fmaxf(m, sc[row][lane + 64 * i]);
            m = wave_max(m); float sum = 0.f;
            for (int i = 0; i < 9; ++i) { const float e = __expf(sc[row][lane + 64 * i] - m); sc[row][lane + 64 * i] = e; sum += e; }
            sum = wave_sum(sum); const float inv = 1.f / sum;
            for (int i = 0; i < 9; ++i) sc[row][lane + 64 * i] *= inv; }
        __syncthreads();
        { const int d = tid & 127, hf = tid >> 7; float acc[8];
#pragma unroll
          for (int i = 0; i < 8; ++i) acc[i] = 0.f;
#pragma unroll 1
          for (int kk = 0; kk < 576; ++kk) { const int kpos = (c - 8) * 64 + kk; if (kpos < 0) continue;
              const float v = bf2f(P[(size_t)kpos * NP + C_AV + h * 128 + d]);
#pragma unroll
              for (int i = 0; i < 8; ++i) acc[i] += sc[hf * 8 + i][kk] * v; }
#pragma unroll
          for (int i = 0; i < 8; ++i) HA[(size_t)(t0 + hf * 8 + i) * 1024 + h * 128 + d] = (bf16)f2bf(acc[i]); }
        __syncthreads();
    }
}

__device__ __forceinline__ void phase_mlstm_local_naive(const Ptrs& p, unsigned char* lds, int wid_) {
    const int TIDX = wid_ * 64 + lane_id();
    const int half = TIDX >> 8, tid = TIDX & 255;
    float (*ks)[128] = (float (*)[128])(lds + half * 33792);
    float* bsh = (float*)(lds + half * 33792 + 32768); float* wsh = bsh + 64;
    const bf16* P = (const bf16*)(p.ws + WS_PROJ); bf16* QC = (bf16*)(p.ws + WS_QC); bf16* KC = (bf16*)(p.ws + WS_KC);
    const float* cw = p.in[3]; const float* cb = p.in[4];
    const float* LI = (const float*)(p.ws + WS_LI); const float* LF = (const float*)(p.ws + WS_LF);
    for (int vb = 2 * blockIdx.x + half; vb < NCH * MH; vb += 2 * gridDim.x) {
        const int c = vb & 127, h = vb >> 7, t0 = c * 64;
        for (int idx = tid; idx < 2 * 64 * 128; idx += 256) {
            const int which = idx >> 13, rem = idx & 8191, t = rem >> 7, ch = rem & 127, gch = which * 512 + h * 128 + ch;
            float a = cb[gch];
#pragma unroll
            for (int tap = 0; tap < 4; ++tap) { const int tt = t0 + t - 3 + tap; if (tt >= 0) a += cw[tap * 1024 + gch] * bf2f(P[(size_t)tt * NP + gch]); }
            float y = a * sigmoidf_(a);
            if (which == 0) QC[(size_t)(t0 + t) * 512 + h * 128 + ch] = (bf16)f2bf(y);
            else { y *= 0.08838834764831845f; const unsigned short b = (unsigned short)f2bf(y); KC[(size_t)(t0 + t) * 512 + h * 128 + ch] = b; ks[t][ch] = bf2f(b); }
        }
        if (tid == 0) {
            float run = 0.f;
            for (int s = 0; s < 64; ++s) { run += LF[h * S + t0 + s]; bsh[s] = run; }
            const float btot = run; float m = -INFINITY;
            for (int s = 0; s < 64; ++s) { const float wl = btot - bsh[s] + LI[h * S + t0 + s]; wsh[s] = wl; m = fmaxf(m, wl); }
            for (int s = 0; s < 64; ++s) wsh[s] = __expf(wsh[s] - m);
            ((float*)(p.ws + WS_MLOC))[h * 128 + c] = m; ((float*)(p.ws + WS_BTOT))[h * 128 + c] = btot;
        }
        __syncthreads();
        { const int dv = tid; float vw[64];
#pragma unroll
          for (int s = 0; s < 64; ++s) vw[s] = bf2f(P[(size_t)(t0 + s) * NP + C_MV + h * 256 + dv]) * wsh[s];
          float* CL = p.out + ((size_t)(h * 128 + c) * 256 + dv) * 128;
#pragma unroll 1
          for (int dk = 0; dk < 128; ++dk) { float sum = 0.f;
#pragma unroll
              for (int s = 0; s < 64; ++s) sum += vw[s] * ks[s][dk];
              CL[dk] = sum; } }
        if (tid < 128) { float sum = 0.f; for (int s = 0; s < 64; ++s) sum += wsh[s] * ks[s][tid]; ((float*)(p.ws + WS_NLOC))[(h * 128 + c) * 128 + tid] = sum; }
        __syncthreads();
    }
}

__device__ __forceinline__ void phase_scan(const Ptrs& p, int wid_) {
    const int TIDX = wid_ * 64 + lane_id();
    float* CL = p.out; const float* MLOC = (const float*)(p.ws + WS_MLOC); const float* BTOT = (const float*)(p.ws + WS_BTOT);
    float* MPREV = (float*)(p.ws + WS_MPREV); const float* NLOC = (const float*)(p.ws + WS_NLOC); float* NPREV = (float*)(p.ws + WS_NPREV);
    const int tid = TIDX;
    for (int vb = blockIdx.x; vb < 256; vb += gridDim.x) {
        const int h = vb >> 6, rest = ((vb & 63) << 9) + tid;
        const bool nthr = ((vb & 63) == 0) && tid < 128, mthr = ((vb & 63) == 0) && tid == 0;
        float m = NEGF, st = 0.f, nst = 0.f;
#pragma unroll 1
        for (int c0 = 0; c0 < NCH; c0 += 8) {
            float val[8], nv[8];
#pragma unroll
            for (int i = 0; i < 8; ++i) { val[i] = CL[((size_t)(h * 128 + c0 + i) << 15) + rest]; nv[i] = nthr ? NLOC[(h * 128 + c0 + i) * 128 + tid] : 0.f; }
#pragma unroll
            for (int i = 0; i < 8; ++i) { const int c = c0 + i;
                const float bt = BTOT[h * 128 + c], ml = MLOC[h * 128 + c];
                CL[((size_t)(h * 128 + c) << 15) + rest] = st;
                if (nthr) NPREV[(h * 128 + c) * 128 + tid] = nst;
                if (mthr) MPREV[h * 128 + c] = m;
                const float mn = fmaxf(bt + m, ml), a = __expf(bt + m - mn), cl = __expf(ml - mn);
                st = a * st + cl * val[i]; nst = a * nst + cl * nv[i]; m = mn; }
        }
    }
}

__device__ __forceinline__ void phase_mlstm_out_naive(const Ptrs& p, unsigned char* lds0, int wid_) {
    const int TIDX = wid_ * 64 + lane_id();
    const int half = TIDX >> 8, tid = TIDX & 255, lane = tid & 63, wave = tid >> 6;
    unsigned char* lds = lds0 + half * 51200;
    float (*qs)[128] = (float (*)[128])lds;
    float (*ps)[64] = (float (*)[64])(lds + 32768);
    float* bsh = (float*)(lds + 49152); float* lish = bsh + 64; float* ash = lish + 64; float* dsh = ash + 64; float* red = dsh + 64;
    const bf16* P = (const bf16*)(p.ws + WS_PROJ); const bf16* QC = (const bf16*)(p.ws + WS_QC); const bf16* KC = (const bf16*)(p.ws + WS_KC);
    const float* LI = (const float*)(p.ws + WS_LI); const float* LF = (const float*)(p.ws + WS_LF);
    bf16* HM = (bf16*)(p.ws + WS_HM);
    for (int vb = 2 * blockIdx.x + half; vb < NCH * MH; vb += 2 * gridDim.x) {
        const int c = vb & 127, h = vb >> 7, t0 = c * 64;
        for (int i = tid; i < 64 * 16; i += 256) { const int t = i >> 4, d0 = (i & 15) * 8; const bf16x8 q = *(const bf16x8*)(QC + (size_t)(t0 + t) * 512 + h * 128 + d0);
#pragma unroll
            for (int e = 0; e < 8; ++e) qs[t][d0 + e] = bf2f((unsigned short)q[e]); }
        if (tid == 0) { float run = 0.f; for (int s = 0; s < 64; ++s) { run += LF[h * S + t0 + s]; bsh[s] = run; lish[s] = LI[h * S + t0 + s]; } }
        __syncthreads();
        const float mprev = ((const float*)(p.ws + WS_MPREV))[h * 128 + c];
        { const int t = tid >> 2, sg = tid & 3; float dot[16]; float mt = bsh[t] + mprev;
#pragma unroll
          for (int si = 0; si < 16; ++si) { const int s = sg * 16 + si; float a = 0.f; const bf16* kr = KC + (size_t)(t0 + s) * 512 + h * 128;
#pragma unroll 1
              for (int d0 = 0; d0 < 16; ++d0) { const bf16x8 kv = *(const bf16x8*)(kr + d0 * 8);
#pragma unroll
                  for (int e = 0; e < 8; ++e) a += qs[t][d0 * 8 + e] * bf2f((unsigned short)kv[e]); }
              dot[si] = a; if (s <= t) mt = fmaxf(mt, bsh[t] - bsh[s] + lish[s]); }
          mt = fmaxf(mt, __shfl_xor(mt, 1)); mt = fmaxf(mt, __shfl_xor(mt, 2));
          float psum = 0.f;
#pragma unroll
          for (int si = 0; si < 16; ++si) { const int s = sg * 16 + si; const float pv = (s <= t) ? __expf(bsh[t] - bsh[s] + lish[s] - mt) * dot[si] : 0.f; ps[t][s] = pv; psum += pv; }
          psum += __shfl_xor(psum, 1); psum += __shfl_xor(psum, 2);
          const float* np = (const float*)(p.ws + WS_NPREV) + (h * 128 + c) * 128; float qn = 0.f;
          for (int dk = sg * 32; dk < sg * 32 + 32; ++dk) qn += qs[t][dk] * np[dk];
          qn += __shfl_xor(qn, 1); qn += __shfl_xor(qn, 2);
          const float ai = __expf(bsh[t] + mprev - mt), den = psum + ai * qn;
          if (sg == 0) { ash[t] = ai; dsh[t] = fmaxf(fabsf(den), __expf(-mt)); } }
        __syncthreads();
        const int dv = tid;
        const float mn = p.in[7][h * 256 + dv];
        const float* cp = p.out + ((size_t)(h * 128 + c) * 256 + dv) * 128;
#pragma unroll 1
        for (int th = 0; th < 4; ++th) {
            float ainter[16], aintra[16];
#pragma unroll
            for (int t = 0; t < 16; ++t) { ainter[t] = 0.f; aintra[t] = 0.f; }
#pragma unroll 1
            for (int dk0 = 0; dk0 < 128; dk0 += 4) { const f32x4 c4 = *(const f32x4*)(cp + dk0);
#pragma unroll
                for (int t = 0; t < 16; ++t) { const f32x4 q4 = *(const f32x4*)(&qs[th * 16 + t][dk0]); ainter[t] += (q4.x * c4.x + q4.y * c4.y) + (q4.z * c4.z + q4.w * c4.w); } }
#pragma unroll 1
            for (int s0 = 0; s0 < 64; s0 += 4) { float vv[4];
#pragma unroll
                for (int e = 0; e < 4; ++e) vv[e] = bf2f(P[(size_t)(t0 + s0 + e) * NP + C_MV + h * 256 + dv]);
#pragma unroll
                for (int t = 0; t < 16; ++t) { const f32x4 p4 = *(const f32x4*)(&ps[th * 16 + t][s0]); aintra[t] += (p4.x * vv[0] + p4.y * vv[1]) + (p4.z * vv[2] + p4.w * vv[3]); } }
            float hv[16];
#pragma unroll
            for (int t = 0; t < 16; ++t) { hv[t] = (aintra[t] + ash[th * 16 + t] * ainter[t]) / dsh[th * 16 + t]; const float ss = wave_sum(hv[t] * hv[t]); if (lane == 0) red[wave * 64 + th * 16 + t] = ss; }
            __syncthreads();
#pragma unroll
            for (int t = 0; t < 16; ++t) { const int tt = th * 16 + t; const float ss = (red[tt] + red[64 + tt]) + (red[128 + tt] + red[192 + tt]); const float r = rsqrtf(ss * (1.f / 256.f) + EPS);
                const float o = bf2f(P[(size_t)(t0 + tt) * NP + C_MO + h * 256 + dv]);
                HM[(size_t)(t0 + tt) * 1024 + h * 256 + dv] = (bf16)f2bf(hv[t] * r * mn * sigmoidf_(o)); }
        }
        __syncthreads();
    }
}

__device__ __forceinline__ void phase_rowstat(const Ptrs& p, int wid_) {
    const int TIDX = wid_ * 64 + lane_id();
    float* RS2 = (float*)(p.ws + WS_RS2); const float* slab = (const float*)(p.ws + WS_SLAB);
    for (int row = blockIdx.x * NTHR + TIDX; row < S; row += gridDim.x * NTHR) { float ss = 0.f;
#pragma unroll
        for (int i = 0; i < 32; ++i) ss += slab[(size_t)i * S + row];
        RS2[row] = rsqrtf(ss * (1.f / D) + EPS); }
}

__device__ __forceinline__ void phase_ffn_conv(const Ptrs& p, int wid_) {
    const int TIDX = wid_ * 64 + lane_id();
    const int lane = TIDX & 63, gw = blockIdx.x * 8 + (TIDX >> 6), NGW = gridDim.x * 8;
    const bf16* U = (const bf16*)(p.ws + WS_U); bf16* ACT = (bf16*)(p.ws + WS_ACT); const float* RS2 = (const float*)(p.ws + WS_RS2);
    const float* cw = p.in[15]; const float* cb = p.in[16];
    constexpr int NCB = DFF / 512, NRB = S / 16;
    for (int unit = gw; unit < NCB * NRB; unit += NGW) {
        const int cbk = unit % NCB, rb = unit / NCB, ch0 = cbk * 512 + lane * 8, j = ch0 >> 7, i0 = ch0 & 127, gcol = 256 * j + i0, vcol = gcol + 128, r0 = rb * 16;
        float w0[8], w1[8], w2[8], bb[8], gm2[8], gm1[8];
#pragma unroll
        for (int e = 0; e < 8; ++e) { w0[e] = cw[ch0 + e]; w1[e] = cw[DFF + ch0 + e]; w2[e] = cw[2 * DFF + ch0 + e]; bb[e] = cb[ch0 + e]; gm2[e] = 0.f; gm1[e] = 0.f; }
        if (r0 >= 2) { const float ra = RS2[r0 - 2], rbv = RS2[r0 - 1];
            const bf16x8 a = *(const bf16x8*)(U + (size_t)(r0 - 2) * NUP + gcol), b = *(const bf16x8*)(U + (size_t)(r0 - 1) * NUP + gcol);
#pragma unroll
            for (int e = 0; e < 8; ++e) { gm2[e] = ra * bf2f((unsigned short)a[e]); gm1[e] = rbv * bf2f((unsigned short)b[e]); } }
#pragma unroll 1
        for (int t = r0; t < r0 + 16; ++t) { const float r = RS2[t];
            const bf16x8 g = *(const bf16x8*)(U + (size_t)t * NUP + gcol), v = *(const bf16x8*)(U + (size_t)t * NUP + vcol); float o[8];
#pragma unroll
            for (int e = 0; e < 8; ++e) { const float g0 = r * bf2f((unsigned short)g[e]); const float cv = bb[e] + w0[e] * gm2[e] + w1[e] * gm1[e] + w2[e] * g0;
                o[e] = cv * sigmoidf_(cv) * (r * bf2f((unsigned short)v[e])); gm2[e] = gm1[e]; gm1[e] = g0; }
            *(u32x4*)(ACT + (size_t)t * DFF + ch0) = (u32x4){pk2(o[0], o[1]), pk2(o[2], o[3]), pk2(o[4], o[5]), pk2(o[6], o[7])}; }
    }
}

__device__ __forceinline__ void phase_final_norm(const Ptrs& p, int wid_) {
    const int TIDX = wid_ * 64 + lane_id();
    const int lane = TIDX & 63, gw = blockIdx.x * 8 + (TIDX >> 6), NGW = gridDim.x * 8;
    const f32x4* g4 = (const f32x4*)p.in[18];
    for (int row = gw; row < S; row += NGW) { f32x4* xr = (f32x4*)(p.out + (size_t)row * D); f32x4 v[8]; float ss = 0.f;
#pragma unroll
        for (int j = 0; j < 8; ++j) { v[j] = xr[64 * j + lane]; ss += (v[j].x * v[j].x + v[j].y * v[j].y) + (v[j].z * v[j].z + v[j].w * v[j].w); }
        const float r = rsqrtf(wave_sum(ss) * (1.f / D) + EPS);
#pragma unroll
        for (int j = 0; j < 8; ++j) xr[64 * j + lane] = v[j] * r * g4[64 * j + lane]; }
}


namespace pg8 {
#define PG8_LAS __attribute__((address_space(3)))
typedef unsigned short bf16_t;
constexpr int BM = 256, BK = 64, HALF = 128, HTB = HALF * BK * 2  , STAGE_BYTES = 8 * HTB, NXCD = 8, WGM = 8;
__host__ __device__ __forceinline__ int lds_byte(int r, int c) { const int st = (r >> 4) * 2 + (c >> 5), rr = r & 15, cc = c & 31, ob = rr * 64 + cc * 2; return st * 1024 + (ob ^ (((ob >> 9) & 1) << 5)); }
__host__ __device__ __forceinline__ void stage_rc(int b, int& R, int& C) { const int st = b / 1024, sb = b % 1024, swz = sb ^ (((sb >> 9) & 1) << 5); R = (st >> 1) * 16 + swz / 64; C = (st & 1) * 32 + (swz % 64) / 2; }
__host__ __device__ __forceinline__ int perm32(int rho) { const int n = rho >> 4, i = rho & 15; return 8 * (i >> 2) + 4 * n + (i & 3); }

struct Unit { int pm, pn, seg; };
struct Gemm { const bf16_t* A; const bf16_t* Bt; const bf16_t* A1; const bf16_t* Bt1; int K;
    __device__ __forceinline__ const char* aptr(const Unit& u) const { return (const char*)(u.seg ? A1 : A) + (size_t)u.pm * BM * K * 2; }
    __device__ __forceinline__ const char* bptr(const Unit& u) const { return (const char*)(u.seg ? Bt1 : Bt) + (size_t)u.pn * BM * K * 2; } };

struct StaticOrder {
    int nM, nN, nwg, G, c, nseg;
    __host__ __device__ void init(int M, int N, int G_, int c_, int nseg_ = 1) { nM = M / BM; nN = N / BM; nwg = nM * nN; G = G_; c = c_; nseg = nseg_; }
    __host__ __device__ bool next(int i, Unit& u) const {
        const int it = i / nseg; u.seg = i - it * nseg;
        const long L = (long)it * G + c; if (L >= nwg) return false;
        int wgid = (int)L; { const int q = nwg / NXCD, r = nwg % NXCD, xcd = wgid % NXCD, off = wgid / NXCD; wgid = (xcd < r ? xcd * (q + 1) : r * (q + 1) + (xcd - r) * q) + off; }
        const int nig = WGM * nN, gid = wgid / nig, fm = gid * WGM, gsz = (nM - fm) < WGM ? (nM - fm) : WGM;
        u.pm = fm + ((wgid % nig) % gsz); u.pn = (wgid % nig) / gsz; return true;
    }
    __device__ __forceinline__ void a_ready(const Unit&) const {}
    __device__ __forceinline__ void done(const Unit&) const {}
};
__device__ __forceinline__ unsigned cvt_pk_bf16(float lo, float hi) { unsigned r; asm volatile("v_cvt_pk_bf16_f32 %0, %1, %2" : "=v"(r) : "v"(lo), "v"(hi)); return r; }

struct EpiBf16 {
    static constexpr bool PERM = true, AFTER_DRAIN = false;
    bf16_t* O; int ldc;
    __device__ __forceinline__ void operator()(f32x4 (&acc)[2][2][4][2], const Unit& u, int wr, int wc, int fr, int fq) const {
        const int row0 = u.pm * BM + wr * 64 + fr, col0 = u.pn * BM + wc * 32 + 8 * fq;
#pragma unroll
        for (int ai = 0; ai < 2; ++ai)
#pragma unroll
            for (int m = 0; m < 4; ++m) { bf16_t* rowp = O + (size_t)(row0 + ai * HALF + m * 16) * ldc + col0;
#pragma unroll
                for (int bj = 0; bj < 2; ++bj) { const f32x4 v0 = acc[ai][bj][m][0], v1 = acc[ai][bj][m][1];
                    u32x4 w; w.x = cvt_pk_bf16(v0[0], v0[1]); w.y = cvt_pk_bf16(v0[2], v0[3]); w.z = cvt_pk_bf16(v1[0], v1[1]); w.w = cvt_pk_bf16(v1[2], v1[3]);
                    *(u32x4*)(rowp + bj * HALF) = w; } }
    }
};

struct EpiResid1 {
    static constexpr bool PERM = true, AFTER_DRAIN = false;
    const float* x; float* out; bf16_t* A2; const float* g; float* slab;
    __device__ __forceinline__ void operator()(f32x4 (&acc)[2][2][4][2], const Unit& u, int wr, int wc, int fr, int fq) const {
        const int row0 = u.pm * BM + wr * 64 + fr, col0 = u.pn * BM + wc * 32 + 8 * fq;
        f32x4 gv[2][2];
#pragma unroll
        for (int bj = 0; bj < 2; ++bj)
#pragma unroll
            for (int n = 0; n < 2; ++n) gv[bj][n] = *(const f32x4*)(g + col0 + bj * HALF + 4 * n);
#pragma unroll
        for (int ai = 0; ai < 2; ++ai)
#pragma unroll
            for (int m = 0; m < 4; ++m) { const int row = row0 + ai * HALF + m * 16; const size_t off = (size_t)row * D + col0; float ss = 0.f;
#pragma unroll
                for (int bj = 0; bj < 2; ++bj) {
                    const f32x4 a0 = *(const f32x4*)(x + off + bj * HALF) + acc[ai][bj][m][0], a1 = *(const f32x4*)(x + off + bj * HALF + 4) + acc[ai][bj][m][1];
                    *(f32x4*)(out + off + bj * HALF) = a0; *(f32x4*)(out + off + bj * HALF + 4) = a1;
                    ss += (a0[0] * a0[0] + a0[1] * a0[1]) + (a0[2] * a0[2] + a0[3] * a0[3]) + (a1[0] * a1[0] + a1[1] * a1[1]) + (a1[2] * a1[2] + a1[3] * a1[3]);
                    const f32x4 b0 = a0 * gv[bj][0], b1 = a1 * gv[bj][1];
                    u32x4 w; w.x = cvt_pk_bf16(b0[0], b0[1]); w.y = cvt_pk_bf16(b0[2], b0[3]); w.z = cvt_pk_bf16(b1[0], b1[1]); w.w = cvt_pk_bf16(b1[2], b1[3]);
                    *(u32x4*)(A2 + off + bj * HALF) = w; }
                ss += __shfl_xor(ss, 16); ss += __shfl_xor(ss, 32);
                if (fq == 0) slab[(size_t)(u.pn * 4 + wc) * S + row] = ss; }
    }
};
struct EpiResid2 {
    static constexpr bool PERM = false, AFTER_DRAIN = false;
    float* out;
    __device__ __forceinline__ void operator()(f32x4 (&acc)[2][2][4][2], const Unit& u, int wr, int wc, int fr, int fq) const {
        const int row0 = u.pm * BM + wr * 64 + fr, col0 = u.pn * BM + wc * 32 + 4 * fq;
#pragma unroll
        for (int ai = 0; ai < 2; ++ai)
#pragma unroll
            for (int m = 0; m < 4; ++m) { const size_t off = (size_t)(row0 + ai * HALF + m * 16) * D + col0;
#pragma unroll
                for (int bj = 0; bj < 2; ++bj)
#pragma unroll
                    for (int n = 0; n < 2; ++n) { float* q = out + off + bj * HALF + n * 16; *(f32x4*)q = *(const f32x4*)q + acc[ai][bj][m][n]; } }
    }
};
struct EpiMerge {
    static constexpr bool PERM = true, AFTER_DRAIN = false;
    const bf16_t* P; const float* gb; bf16_t* O;
    __device__ __forceinline__ void operator()(f32x4 (&acc)[2][2][4][2], const Unit& u, int wr, int wc, int fr, int fq) const {
        const int row0 = u.pm * BM + wr * 64 + fr, col0 = u.pn * BM + wc * 32 + 8 * fq;
        f32x4 bm[2][2], ba[2][2];
#pragma unroll
        for (int bj = 0; bj < 2; ++bj)
#pragma unroll
            for (int n = 0; n < 2; ++n) { bm[bj][n] = *(const f32x4*)(gb + col0 + bj * HALF + 4 * n); ba[bj][n] = *(const f32x4*)(gb + D + col0 + bj * HALF + 4 * n); }
        const bool mid = (u.seg == 0);
#pragma unroll
        for (int ai = 0; ai < 2; ++ai)
#pragma unroll
            for (int m = 0; m < 4; ++m) { const int row = row0 + ai * HALF + m * 16; const bf16_t* prow = P + (size_t)row * NP + col0;
#pragma unroll
                for (int bj = 0; bj < 2; ++bj) {
                    const bf16x8 ga8 = *(const bf16x8*)(prow + C_GA + bj * HALF);
                    float ea[8];
#pragma unroll
                    for (int e = 0; e < 8; ++e) ea[e] = __expf(fminf(-(bf2f((unsigned short)ga8[e]) + ba[bj][e >> 2][e & 3]), 80.f));
                    if (mid) {
                        const bf16x8 gm8 = *(const bf16x8*)(prow + C_GM + bj * HALF);
#pragma unroll
                        for (int e = 0; e < 8; ++e) { const float em = __expf(fminf(-(bf2f((unsigned short)gm8[e]) + bm[bj][e >> 2][e & 3]), 80.f));
                            acc[ai][bj][m][e >> 2][e & 3] *= (1.f + ea[e]) / (1.f + em); }
                    } else {
                        float v[8];
#pragma unroll
                        for (int e = 0; e < 8; ++e) v[e] = acc[ai][bj][m][e >> 2][e & 3] / (1.f + ea[e]);
                        u32x4 w; w.x = cvt_pk_bf16(v[0], v[1]); w.y = cvt_pk_bf16(v[2], v[3]); w.z = cvt_pk_bf16(v[4], v[5]); w.w = cvt_pk_bf16(v[6], v[7]);
                        *(u32x4*)(O + (size_t)row * D + col0 + bj * HALF) = w; } } }
    }
};
template <class Epi, class Sched, bool ALIGN_EPI = false, bool SP2 = false>
__device__ __forceinline__ void gemm_phase(PG8_LAS unsigned char* lds, const Gemm g, const Sched& S, const Epi& E, int wid_) {
    const int wid = wid_, lane = lane_id(), tid = wid * 64 + lane, wr = wid >> 2, wc = wid & 3, fr = lane & 15, fq = lane >> 4;
    const int K = g.K, nt = K / BK;
    unsigned voffA[2], voffB[2];
#pragma unroll
    for (int i = 0; i < 2; ++i) { int R, C; stage_rc(tid * 16 + i * 8192, R, C); const int Rb = Epi::PERM ? ((R & ~31) + perm32(R & 31)) : R;
        voffA[i] = (unsigned)(R * K + C) * 2u; voffB[i] = (unsigned)(Rb * K + C) * 2u; }
    const size_t kstep = (size_t)(BK * 2);
    const size_t hstep = (size_t)HALF * K * 2;
        const unsigned ldsw = (unsigned)wid * 1024u;
    const int aoff = lds_byte(wr * 64 + fr, fq * 8), boff = lds_byte(wc * 32 + fr, fq * 8);
#define PG8_SA(b, h) (((b) * 2 + (h)) * HTB)
#define PG8_SB(b, h) ((4 + (b) * 2 + (h)) * HTB)
#define PG8_STAGE(bufoff, gbase, voff) do { _Pragma("unroll") for (int _i = 0; _i < 2; ++_i) \
        __builtin_amdgcn_global_load_lds((const unsigned*)((const char*)(gbase) + (voff)[_i]), (PG8_LAS unsigned*)(lds + (bufoff) + ldsw + _i * 8192), 16, 0, 0); } while (0)
#define PG8_LDA(dst, b, h) do { _Pragma("unroll") for (int m = 0; m < 4; ++m) _Pragma("unroll") for (int k = 0; k < 2; ++k) dst[m][k] = *(const PG8_LAS bf16x8*)(lds + PG8_SA(b, h) + aoff + m * 2048 + k * 1024); } while (0)
#define PG8_LDB(dst, b, h) do { _Pragma("unroll") for (int n = 0; n < 2; ++n) _Pragma("unroll") for (int k = 0; k < 2; ++k) dst[n][k] = *(const PG8_LAS bf16x8*)(lds + PG8_SB(b, h) + boff + n * 2048 + k * 1024); } while (0)
#define PG8_MMA(ai, bj, At, Bt) do { __builtin_amdgcn_s_setprio(1); _Pragma("unroll") for (int m = 0; m < 4; ++m) _Pragma("unroll") for (int n = 0; n < 2; ++n) _Pragma("unroll") for (int k = 0; k < 2; ++k) \
        acc[ai][bj][m][n] = __builtin_amdgcn_mfma_f32_16x16x32_bf16(Bt[n][k], At[m][k], acc[ai][bj][m][n], 0, 0, 0); __builtin_amdgcn_s_setprio(0); } while (0)
#define PG8_WAIT_V(n) asm volatile("s_waitcnt vmcnt(" #n ")" ::: "memory")
#define PG8_WAIT_L(n) asm volatile("s_waitcnt lgkmcnt(" #n ")" ::: "memory")
#define PG8_BAR __builtin_amdgcn_s_barrier()
#define PG8_SCHED __builtin_amdgcn_sched_barrier(0)
    Unit cur, nxt; int ui = 0;
    if (!S.next(0, cur)) return;
    f32x4 acc[2][2][4][2];
#pragma unroll
    for (int a = 0; a < 2; ++a)
#pragma unroll
        for (int b = 0; b < 2; ++b)
#pragma unroll
            for (int m = 0; m < 4; ++m)
#pragma unroll
                for (int n = 0; n < 2; ++n) acc[a][b][m][n] = (f32x4){0.f, 0.f, 0.f, 0.f};
    bf16x8 At[4][2], B0[2][2], B1[2][2];
    const char* cA = g.aptr(cur); const char* cB = g.bptr(cur);
    S.a_ready(cur);
    if constexpr (SP2) {
        PG8_STAGE(PG8_SB(0, 0), cB, voffB); PG8_STAGE(PG8_SB(0, 1), cB + hstep, voffB); PG8_STAGE(PG8_SA(0, 0), cA, voffA); PG8_STAGE(PG8_SA(0, 1), cA + hstep, voffA);
        if (wr == 1) PG8_BAR;
        PG8_WAIT_V(2); PG8_BAR;
        PG8_STAGE(PG8_SB(1, 0), cB + kstep, voffB); PG8_STAGE(PG8_SA(1, 0), cA + kstep, voffA); PG8_STAGE(PG8_SB(1, 1), cB + hstep + kstep, voffB);
        PG8_WAIT_V(6); PG8_BAR;
    } else {
        PG8_STAGE(PG8_SB(0, 0), cB, voffB); PG8_STAGE(PG8_SA(0, 0), cA, voffA); PG8_STAGE(PG8_SB(0, 1), cB + hstep, voffB); PG8_STAGE(PG8_SA(0, 1), cA + hstep, voffA);
        if (wr == 1) PG8_BAR;
        PG8_WAIT_V(4); PG8_BAR;
        PG8_STAGE(PG8_SB(1, 0), cB + kstep, voffB); PG8_STAGE(PG8_SA(1, 0), cA + kstep, voffA); PG8_STAGE(PG8_SB(1, 1), cB + hstep + kstep, voffB);
        PG8_WAIT_V(6); PG8_BAR;
    }
    for (;;) {
        const bool has_next = S.next(ui + 1, nxt);
        const char* nA = has_next ? g.aptr(nxt) : cA; const char* nB = has_next ? g.bptr(nxt) : cB;
        for (int t = 0; t < nt; t += 2) {
            const bool last = (t == nt - 2);
            const char* a1 = cA + (size_t)(t + 1) * kstep;
            const char* a2 = last ? nA : cA + (size_t)(t + 2) * kstep; const char* b2 = last ? nB : cB + (size_t)(t + 2) * kstep;
            const char* a3 = a2 + kstep; const char* b3 = b2 + kstep;
            if (last && has_next) S.a_ready(nxt);
            if constexpr (SP2) {
            PG8_LDB(B0, 0, 0); PG8_LDB(B1, 0, 1); PG8_SCHED; PG8_LDA(At, 0, 0); PG8_STAGE(PG8_SA(1, 1), a1 + hstep, voffA);
            PG8_WAIT_V(8); PG8_WAIT_L(0); PG8_BAR; PG8_MMA(0, 0, At, B0); PG8_MMA(0, 1, At, B1); PG8_BAR; PG8_SCHED;
            PG8_LDA(At, 0, 1); PG8_STAGE(PG8_SB(0, 0), b2, voffB); PG8_STAGE(PG8_SB(0, 1), b2 + hstep, voffB); PG8_STAGE(PG8_SA(0, 0), a2, voffA);
            PG8_WAIT_V(8); PG8_WAIT_L(0); PG8_BAR; PG8_MMA(1, 0, At, B0); PG8_MMA(1, 1, At, B1); PG8_BAR; PG8_SCHED;
            PG8_LDB(B0, 1, 0); PG8_LDB(B1, 1, 1); PG8_SCHED; PG8_LDA(At, 1, 0); PG8_STAGE(PG8_SA(0, 1), a2 + hstep, voffA);
            PG8_WAIT_V(8); PG8_WAIT_L(0); PG8_BAR; PG8_MMA(0, 0, At, B0); PG8_MMA(0, 1, At, B1); PG8_BAR; PG8_SCHED;
            PG8_LDA(At, 1, 1); PG8_STAGE(PG8_SB(1, 0), b3, voffB); PG8_STAGE(PG8_SB(1, 1), b3 + hstep, voffB); PG8_STAGE(PG8_SA(1, 0), a3, voffA);
            PG8_WAIT_V(8); PG8_WAIT_L(0); PG8_BAR; PG8_MMA(1, 0, At, B0); PG8_MMA(1, 1, At, B1); PG8_BAR; PG8_SCHED;
            } else {
            PG8_LDB(B0, 0, 0); PG8_SCHED; PG8_LDA(At, 0, 0); PG8_STAGE(PG8_SA(1, 1), a1 + hstep, voffA);
            PG8_WAIT_L(8); PG8_BAR; PG8_WAIT_L(0); PG8_MMA(0, 0, At, B0); PG8_BAR; PG8_SCHED;
            PG8_LDB(B1, 0, 1); PG8_STAGE(PG8_SB(0, 0), b2, voffB);
            PG8_BAR; PG8_WAIT_L(0); PG8_MMA(0, 1, At, B1); PG8_BAR;
            PG8_LDA(At, 0, 1); PG8_STAGE(PG8_SA(0, 0), a2, voffA);
            PG8_BAR; PG8_WAIT_L(0); PG8_MMA(1, 0, At, B0); PG8_BAR; PG8_SCHED;
            PG8_STAGE(PG8_SB(0, 1), b2 + hstep, voffB);
            PG8_WAIT_V(6); PG8_BAR; PG8_MMA(1, 1, At, B1); PG8_BAR;
            PG8_LDB(B0, 1, 0); PG8_SCHED; PG8_LDA(At, 1, 0); PG8_STAGE(PG8_SA(0, 1), a2 + hstep, voffA);
            PG8_WAIT_L(8); PG8_BAR; PG8_WAIT_L(0); PG8_MMA(0, 0, At, B0); PG8_BAR; PG8_SCHED;
            PG8_LDB(B1, 1, 1); PG8_STAGE(PG8_SB(1, 0), b3, voffB);
            PG8_BAR; PG8_WAIT_L(0); PG8_MMA(0, 1, At, B1); PG8_BAR;
            PG8_LDA(At, 1, 1); PG8_STAGE(PG8_SA(1, 0), a3, voffA);
            PG8_BAR; PG8_WAIT_L(0); PG8_MMA(1, 0, At, B0); PG8_BAR; PG8_SCHED;
            PG8_STAGE(PG8_SB(1, 1), b3 + hstep, voffB);
            PG8_WAIT_V(6); PG8_BAR; PG8_MMA(1, 1, At, B1); PG8_BAR;
            }
        }
        if constexpr (ALIGN_EPI) { if (wr == 0) PG8_BAR; }
        if constexpr (!Epi::AFTER_DRAIN) { E(acc, cur, wr, wc, fr, fq); S.done(cur); }
        if (!has_next) break;
        if (nxt.seg == 0)
#pragma unroll
        for (int a = 0; a < 2; ++a)
#pragma unroll
            for (int b = 0; b < 2; ++b)
#pragma unroll
                for (int m = 0; m < 4; ++m)
#pragma unroll
                    for (int n = 0; n < 2; ++n) acc[a][b][m][n] = (f32x4){0.f, 0.f, 0.f, 0.f};
        cur = nxt; cA = nA; cB = nB; ++ui;
        if constexpr (ALIGN_EPI) { if (wr == 1) PG8_BAR; }
    }
    PG8_WAIT_V(0);
    if constexpr (!ALIGN_EPI) { if (wr == 0) PG8_BAR; }
    PG8_BAR;
    if constexpr (Epi::AFTER_DRAIN) { E.fused(acc, cur, wr, wc, fr, fq, lds, wid, lane); S.done(cur); }
#undef PG8_SA
#undef PG8_SB
#undef PG8_STAGE
#undef PG8_LDA
#undef PG8_LDB
#undef PG8_MMA
#undef PG8_WAIT_V
#undef PG8_WAIT_L
#undef PG8_BAR
#undef PG8_SCHED
}
}


namespace att {
using s16x4 = __attribute__((ext_vector_type(4))) short;
using f32x16 = __attribute__((ext_vector_type(16))) float;
#define KSWZ(row, colB) ((row) * 256 + ((colB) ^ (((row) & 7) << 4)))
#define SBAR() __builtin_amdgcn_sched_barrier(0)
__device__ __forceinline__ int crow(int r, int hi) { return (r & 3) + 8 * (r >> 2) + 4 * hi; }
__device__ __forceinline__ unsigned cvtpk(float lo, float hi) { unsigned r; asm volatile("v_cvt_pk_bf16_f32 %0, %1, %2" : "=v"(r) : "v"(lo), "v"(hi)); return r; }
__device__ __forceinline__ int v_st(int k, int c) { const int kk = (k & ~0xC) | ((k & 4) << 1) | ((k & 8) >> 1); return ((kk >> 3) * 4 + (c >> 5)) * 512 + ((kk & 7) * 32 + (c & 31)) * 2; }
__device__ __forceinline__ int v_rd_base(int lane) { return ((lane & 3) << 3) | (((lane >> 2) & 3) << 6) | (((lane >> 4) & 1) << 5) | (((lane >> 5) & 1) << 8); }
constexpr int v_rd_off(int d0, int ks, int half) { return d0 * 512 + ks * 4096 + half * 2048; }
template <int OFF> __device__ __forceinline__ s16x4 tr_read(int vb) { s16x4 r; asm volatile("ds_read_b64_tr_b16 %0, %1 offset:%2" : "=&v"(r) : "v"(vb), "i"(OFF) : "memory"); return r; }
#define ATT_PK(L, H) (bf16x8){L[0], L[1], L[2], L[3], H[0], H[1], H[2], H[3]}
template <int D0> __device__ __forceinline__ void frag4(int vb, bf16x8& f0, bf16x8& f1, bf16x8& f2, bf16x8& f3) {
    const s16x4 l0 = tr_read<v_rd_off(D0, 0, 0)>(vb), h0 = tr_read<v_rd_off(D0, 0, 1)>(vb), l1 = tr_read<v_rd_off(D0, 1, 0)>(vb), h1 = tr_read<v_rd_off(D0, 1, 1)>(vb);
    const s16x4 l2 = tr_read<v_rd_off(D0, 2, 0)>(vb), h2 = tr_read<v_rd_off(D0, 2, 1)>(vb), l3 = tr_read<v_rd_off(D0, 3, 0)>(vb), h3 = tr_read<v_rd_off(D0, 3, 1)>(vb);
    asm volatile("s_waitcnt lgkmcnt(0)" ::: "memory"); SBAR();
    f0 = ATT_PK(l0, h0); f1 = ATT_PK(l1, h1); f2 = ATT_PK(l2, h2); f3 = ATT_PK(l3, h3);
}
template <int D0> __device__ __forceinline__ void pv_one(f32x16& od, int vb, bf16x8 pa0, bf16x8 pa1, bf16x8 pa2, bf16x8 pa3) {
    bf16x8 f0, f1, f2, f3; frag4<D0>(vb, f0, f1, f2, f3);
    od = __builtin_amdgcn_mfma_f32_32x32x16_bf16(pa0, f0, od, 0, 0, 0);
    od = __builtin_amdgcn_mfma_f32_32x32x16_bf16(pa1, f1, od, 0, 0, 0);
    od = __builtin_amdgcn_mfma_f32_32x32x16_bf16(pa2, f2, od, 0, 0, 0);
    od = __builtin_amdgcn_mfma_f32_32x32x16_bf16(pa3, f3, od, 0, 0, 0);
}
__device__ __forceinline__ void qkt(f32x16& p0, f32x16& p1, const char* Ks, const bf16x8* qr, int r32, int hi) {
#pragma unroll
    for (int d0 = 0; d0 < 8; ++d0) { const int cb = (d0 * 16 + hi * 8) * 2;
        const bf16x8 b0 = *reinterpret_cast<const bf16x8*>(Ks + KSWZ(r32, cb));
        const bf16x8 b1 = *reinterpret_cast<const bf16x8*>(Ks + KSWZ(32 + r32, cb));
        p0 = __builtin_amdgcn_mfma_f32_32x32x16_bf16(b0, qr[d0], p0, 0, 0, 0);
        p1 = __builtin_amdgcn_mfma_f32_32x32x16_bf16(b1, qr[d0], p1, 0, 0, 0); }
}
__device__ __forceinline__ void pack_p(const f32x16& p0, const f32x16& p1, bf16x8& pa0, bf16x8& pa1, bf16x8& pa2, bf16x8& pa3) {
#define ATT_PK4(P, BASE, OUT) do { unsigned a0 = cvtpk(P[BASE + 0], P[BASE + 1]), a1 = cvtpk(P[BASE + 2], P[BASE + 3]);   \
    unsigned b0 = cvtpk(P[BASE + 4], P[BASE + 5]), b1 = cvtpk(P[BASE + 6], P[BASE + 7]);                              \
    auto r0 = __builtin_amdgcn_permlane32_swap(a0, b0, false, false); auto r1 = __builtin_amdgcn_permlane32_swap(a1, b1, false, false); \
    u32x4 w = {r0[0], r1[0], r0[1], r1[1]}; OUT = *reinterpret_cast<bf16x8*>(&w); } while (0)
    ATT_PK4(p0, 0, pa0); ATT_PK4(p0, 8, pa1); ATT_PK4(p1, 0, pa2); ATT_PK4(p1, 8, pa3);
#undef ATT_PK4
}
__device__ __forceinline__ float swap_max(float v) { auto rr = __builtin_amdgcn_permlane32_swap(__float_as_uint(v), __float_as_uint(v), false, false); return fmaxf(__uint_as_float(rr[0]), __uint_as_float(rr[1])); }
__device__ __forceinline__ float swap_add(float v) { auto rr = __builtin_amdgcn_permlane32_swap(__float_as_uint(v), __float_as_uint(v), false, false); return __uint_as_float(rr[0]) + __uint_as_float(rr[1]); }

constexpr float SCALE = 0.088388347648318440f, SQ = 11.313708498984761f, CL2 = SCALE * 1.4426950408889634f;
__device__ __forceinline__ void phase_attn(const Ptrs& p, unsigned char* lds, int wid_) {
    const int wid = wid_, lane = lane_id(), tid = wid * 64 + lane, r32 = lane & 31, hi = lane >> 5;
    char* V_lds = (char*)lds; char* K_lds = (char*)lds + 32768;
    float* wsf = (float*)(lds + 65536) + wid * 64; float* biasR = (float*)(lds + 65536 + 2048);
    const bf16* P = (const bf16*)(p.ws + WS_PROJ); bf16* HA = (bf16*)(p.ws + WS_HA);
    const int sr = tid >> 4, sc = (tid & 15) * 8, vst0 = v_st(sr, sc), vst1 = v_st(32 + sr, sc);
    const int vb0 = (int)(uintptr_t)V_lds + v_rd_base(lane);
    for (int unit = blockIdx.x; unit < AH * (S / 256); unit += gridDim.x) {
        const int h = unit & 7, u = unit >> 3;
        __syncthreads();
        if (tid < 320) { const int e = 319 - tid; biasR[tid] = SQ * p.in[8][h * 257 + (e > 256 ? 256 : e)]; }
        bf16x8 qr[8];
        { const bf16* Qw = P + (size_t)(256 * u + 32 * wid + r32) * NP + C_AQ + h * 128 + hi * 8;
#pragma unroll
          for (int d0 = 0; d0 < 8; ++d0) qr[d0] = *(const bf16x8*)(Qw + d0 * 16); }
        const int qi = wid >> 1, qin = 32 * (wid & 1) + r32;
        const int j0 = (8 - 4 * u) > 0 ? (8 - 4 * u) : 0;
        const bf16* Kg = P + C_AK + h * 128 + sc; const bf16* Vg = P + C_AV + h * 128 + sc;
        bf16x8 vs0, vs1, ks0, ks1;
#define ASLOAD(j) do { const size_t r0_ = (size_t)((4 * u - 8 + (j)) * 64 + sr) * NP; vs0 = *(const bf16x8*)(Vg + r0_); vs1 = *(const bf16x8*)(Vg + r0_ + (size_t)32 * NP); \
        ks0 = *(const bf16x8*)(Kg + r0_); ks1 = *(const bf16x8*)(Kg + r0_ + (size_t)32 * NP); } while (0)
#define ASWRITE(b) do { *(bf16x8*)(V_lds + (b) * 16384 + vst0) = vs0; *(bf16x8*)(V_lds + (b) * 16384 + vst1) = vs1; const int kc_ = sc * 2; \
        *(bf16x8*)(K_lds + (b) * 16384 + KSWZ(sr, kc_)) = ks0; *(bf16x8*)(K_lds + (b) * 16384 + KSWZ(32 + sr, kc_)) = ks1; } while (0)
        ASLOAD(j0); ASWRITE(0);
        __syncthreads();
        float m_reg = -1e30f, l_reg = 0.f; f32x16 o[4];
#pragma unroll
        for (int d = 0; d < 4; ++d)
#pragma unroll
            for (int r = 0; r < 16; ++r) o[d][r] = 0.f;
        for (int j = j0; j < 12; ++j) {
            const int cur = (j - j0) & 1;
            if (j + 1 < 12) ASLOAD(j + 1);
            if (j >= qi && j <= qi + 8) {
                const int dlt = qi + 8 - j;
                f32x16 p0, p1;
                if (dlt >= 3) { const float cf = biasR[0];
#pragma unroll
                    for (int r = 0; r < 16; ++r) { p0[r] = cf; p1[r] = cf; } }
                else { const float* bp = biasR + (191 - qin - 64 * dlt + 4 * hi);
#pragma unroll
                    for (int r = 0; r < 16; ++r) { p0[r] = bp[(r & 3) + 8 * (r >> 2)]; p1[r] = bp[32 + (r & 3) + 8 * (r >> 2)]; } }
                qkt(p0, p1, K_lds + cur * 16384, qr, r32, hi);
                float pmax = p0[0];
#pragma unroll
                for (int r = 1; r < 16; ++r) pmax = fmaxf(pmax, p0[r]);
#pragma unroll
                for (int r = 0; r < 16; ++r) pmax = fmaxf(pmax, p1[r]);
                pmax = swap_max(pmax);
                const float mn = fmaxf(m_reg, pmax), alpha = __builtin_amdgcn_exp2f((m_reg - mn) * CL2); m_reg = mn;
                const float mnC = -mn * CL2; float ps = 0.f;
#pragma unroll
                for (int r = 0; r < 16; ++r) { p0[r] = __builtin_amdgcn_exp2f(fmaf(p0[r], CL2, mnC)); p1[r] = __builtin_amdgcn_exp2f(fmaf(p1[r], CL2, mnC)); ps += p0[r] + p1[r]; }
                ps = swap_add(ps); l_reg = l_reg * alpha + ps;
                if (__any(alpha < 1.f)) { if (hi == 0) wsf[r32] = alpha; asm volatile("s_waitcnt lgkmcnt(0)" ::: "memory");
#pragma unroll
                    for (int d = 0; d < 4; ++d)
#pragma unroll
                        for (int r = 0; r < 16; ++r) o[d][r] *= wsf[crow(r, hi)]; }
                bf16x8 pa0, pa1, pa2, pa3; pack_p(p0, p1, pa0, pa1, pa2, pa3);
                const int vb = vb0 + cur * 16384;
                pv_one<0>(o[0], vb, pa0, pa1, pa2, pa3); pv_one<1>(o[1], vb, pa0, pa1, pa2, pa3); pv_one<2>(o[2], vb, pa0, pa1, pa2, pa3); pv_one<3>(o[3], vb, pa0, pa1, pa2, pa3);
            }
            if (j + 1 < 12) ASWRITE(cur ^ 1);
            __syncthreads();
        }
#undef ASLOAD
#undef ASWRITE
        if (hi == 0) wsf[32 + r32] = l_reg; asm volatile("s_waitcnt lgkmcnt(0)" ::: "memory");
        bf16* Ow = HA + (size_t)(256 * u + 32 * wid) * 1024 + h * 128 + r32;
#pragma unroll
        for (int r = 0; r < 16; ++r) { const int orow = crow(r, hi); const float rl = __builtin_amdgcn_rcpf(wsf[32 + orow]);
#pragma unroll
            for (int d0 = 0; d0 < 4; ++d0) Ow[(size_t)orow * 1024 + d0 * 32] = (bf16)f2bf(o[d0][r] * rl); }
    }
}
}

__global__ void __launch_bounds__(NTHR, 2) mega(Ptrs p) {
    extern __shared__ __attribute__((aligned(16))) unsigned char lds[];
    cg::grid_group grid = cg::this_grid();
    const int WID = __builtin_amdgcn_readfirstlane((int)threadIdx.x >> 6);
    unsigned char* ws = p.ws;
    bf16* WIN = (bf16*)(ws + WS_WIN); bf16* XN = (bf16*)(ws + WS_XN); bf16* PROJ = (bf16*)(ws + WS_PROJ);
    bf16* WM = (bf16*)(ws + WS_WM); bf16* WA = (bf16*)(ws + WS_WA); bf16* WO = (bf16*)(ws + WS_WO); bf16* WUP = (bf16*)(ws + WS_WUP); bf16* WDN = (bf16*)(ws + WS_WDN);
    bf16* HM = (bf16*)(ws + WS_HM); bf16* HA = (bf16*)(ws + WS_HA); bf16* MRG = (bf16*)(ws + WS_MRG); bf16* A2 = (bf16*)(ws + WS_A2); bf16* U = (bf16*)(ws + WS_U); bf16* ACT = (bf16*)(ws + WS_ACT);
    phase_transpose(p, lds, WID);
    __syncthreads();
    phase_norm_gates(p, lds, WID);
    grid.sync();
    { pg8::Gemm g{XN, WIN, nullptr, nullptr, D}; pg8::StaticOrder So; So.init(S, NP, gridDim.x, blockIdx.x); pg8::EpiBf16 E{PROJ, NP};
      pg8::gemm_phase<pg8::EpiBf16, pg8::StaticOrder, true, true>((PG8_LAS unsigned char*)lds, g, So, E, WID); }
    grid.sync();
    att::phase_attn(p, lds, WID);
    __syncthreads();
    phase_mlstm_local_naive(p, lds, WID);
    grid.sync();
    phase_scan(p, WID);
    grid.sync();
    phase_mlstm_out_naive(p, lds, WID);
    grid.sync();
    { pg8::Gemm g{HM, WM, HA, WA, 1024}; pg8::StaticOrder So; So.init(S, D, gridDim.x, blockIdx.x, 2); pg8::EpiMerge E{PROJ, p.in[9], MRG};
      pg8::gemm_phase<pg8::EpiMerge, pg8::StaticOrder, true, true>((PG8_LAS unsigned char*)lds, g, So, E, WID); }
    grid.sync();
    { pg8::Gemm g{MRG, WO, nullptr, nullptr, D}; pg8::StaticOrder So; So.init(S, D, gridDim.x, blockIdx.x); pg8::EpiResid1 E{p.in[0], p.out, A2, p.in[13], (float*)(ws + WS_SLAB)};
      pg8::gemm_phase<pg8::EpiResid1, pg8::StaticOrder, false, true>((PG8_LAS unsigned char*)lds, g, So, E, WID); }
    grid.sync();
    phase_rowstat(p, WID);
    { pg8::Gemm g{A2, WUP, nullptr, nullptr, D}; pg8::StaticOrder So; So.init(S, NUP, gridDim.x, blockIdx.x); pg8::EpiBf16 E{U, NUP};
      pg8::gemm_phase<pg8::EpiBf16, pg8::StaticOrder, true, true>((PG8_LAS unsigned char*)lds, g, So, E, WID); }
    grid.sync();
    phase_ffn_conv(p, WID);
    grid.sync();
    { pg8::Gemm g{ACT, WDN, nullptr, nullptr, DFF}; pg8::StaticOrder So; So.init(S, D, gridDim.x, blockIdx.x); pg8::EpiResid2 E{p.out};
      pg8::gemm_phase<pg8::EpiResid2, pg8::StaticOrder, false, true>((PG8_LAS unsigned char*)lds, g, So, E, WID); }
    grid.sync();
    phase_final_norm(p, WID);
}

extern "C" void kernel_launch(void* const* d_in, const int* in_sizes, int n_in, void* d_out, int out_size, void* d_ws, size_t ws_size, hipStream_t stream) {
    static int grid_blocks = 0;
    if (grid_blocks == 0) {
        if (n_in != 19 || out_size != S * D || ws_size < WS_END) { fprintf(stderr, "kernel_launch: unexpected shapes n_in %d out %d ws %zu\n", n_in, out_size, ws_size); grid_blocks = -1; return; }
        int dev = 0, cus = 0, per_cu = 0;
        (void)hipGetDevice(&dev);
        (void)hipDeviceGetAttribute(&cus, hipDeviceAttributeMultiprocessorCount, dev);
        (void)hipFuncSetAttribute((const void*)mega, hipFuncAttributeMaxDynamicSharedMemorySize, LDS_BYTES);
        (void)hipOccupancyMaxActiveBlocksPerMultiprocessor(&per_cu, (const void*)mega, NTHR, LDS_BYTES);
        if (per_cu < 1) { fprintf(stderr, "kernel_launch: occupancy query returned %d\n", per_cu); per_cu = 1; }
        if (per_cu > 1) per_cu = 1;
        grid_blocks = cus * per_cu;
        fprintf(stderr, "kernel_launch: cus %d per_cu %d grid %d\n", cus, per_cu, grid_blocks);
    }
    if (grid_blocks < 0) return;
    Ptrs p{};
    for (int i = 0; i < 19; ++i) p.in[i] = (const float*)d_in[i];
    p.out = (float*)d_out; p.ws = (unsigned char*)d_ws;
    void* args[] = {&p};
    hipError_t e = hipLaunchCooperativeKernel((const void*)mega, dim3(grid_blocks), dim3(NTHR), args, LDS_BYTES, stream);
    if (e != hipSuccess) fprintf(stderr, "cooperative launch failed: %s (grid %d)\n", hipGetErrorString(e), grid_blocks);
}
```

```cpp
#include <hip/hip_runtime.h>
#include <cstdint>
#include <cstdio>
#include <hip/hip_cooperative_groups.h>
namespace cg = cooperative_groups;

typedef unsigned short bf16;
typedef short bf16x8 __attribute__((ext_vector_type(8)));
typedef float f32x4 __attribute__((ext_vector_type(4)));
typedef unsigned u32x4 __attribute__((ext_vector_type(4)));
typedef unsigned u32x2 __attribute__((ext_vector_type(2)));

constexpr int S = 8192, D = 2048, WIN_N = 10248, NP = 10240, DFF = 5632, NUP = 11264;
constexpr int CH = 64, NCH = 128;
constexpr int MH = 4, MDK = 128, MDV = 256, AH = 8, ADH = 128;
constexpr int C_MQ = 0, C_MK = 512, C_MV = 1024, C_MO = 2048, C_AQ = 3072, C_AK = 4096, C_AV = 5120, C_GM = 6144, C_GA = 8192;
constexpr float EPS = 1e-6f, NEGF = -1e30f;

constexpr size_t MiB = 1u << 20;
constexpr size_t WS_WIN = 0;
constexpr size_t WS_XN = 40 * MiB;
constexpr size_t WS_QC = 0;
constexpr size_t WS_KC = 8 * MiB;
constexpr size_t WS_A2 = 0;
constexpr size_t WS_MRG = 32 * MiB;
constexpr size_t WS_ACT = 0;
constexpr size_t WS_WM = 72 * MiB, WS_WA = 76 * MiB, WS_WO = 80 * MiB, WS_WUP = 88 * MiB, WS_WDN = 132 * MiB;
constexpr size_t WS_PROJ = 154 * MiB;
constexpr size_t WS_HM = 314 * MiB, WS_HA = 330 * MiB;
constexpr size_t WS_U = 154 * MiB;
constexpr size_t WS_MISC = 346 * MiB;
constexpr size_t WS_LI = WS_MISC, WS_LF = WS_LI + 131072, WS_MLOC = WS_LF + 131072, WS_BTOT = WS_MLOC + 2048, WS_MPREV = WS_BTOT + 2048,
                 WS_NLOC = WS_MPREV + 2048, WS_NPREV = WS_NLOC + 262144, WS_RS2 = WS_NPREV + 262144, WS_SLAB = WS_RS2 + 32768, WS_END = WS_SLAB + 32 * 8192 * 4;
static_assert(WS_END <= 348 * MiB, "ws map");

__device__ __forceinline__ unsigned f2bf(float f) { unsigned u = __builtin_bit_cast(unsigned, f); return (u + 0x7fffu + ((u >> 16) & 1u)) >> 16; }
__device__ __forceinline__ float bf2f(unsigned short b) { return __builtin_bit_cast(float, (unsigned)b << 16); }
__device__ __forceinline__ unsigned pk2(float lo, float hi) { return f2bf(lo) | (f2bf(hi) << 16); }
__device__ __forceinline__ float wave_sum(float v) {
#pragma unroll
    for (int o = 1; o < 64; o <<= 1) v += __shfl_xor(v, o);
    return v;
}
__device__ __forceinline__ float wave_max(float v) {
#pragma unroll
    for (int o = 1; o < 64; o <<= 1) v = fmaxf(v, __shfl_xor(v, o));
    return v;
}
__device__ __forceinline__ int lane_id() { int r; asm volatile("v_mbcnt_lo_u32_b32 %0, -1, 0\n\tv_mbcnt_hi_u32_b32 %0, -1, %0" : "=v"(r)); return r; }
__device__ __forceinline__ float sigmoidf_(float x) { return 1.f / (1.f + __expf(-x)); }

__device__ __forceinline__ int src_col(int mode, int n0) {
    if (mode == 1) return n0 < 3072 ? n0 : n0 + 8;
    if (mode == 2) { const int j = n0 >> 8, i = n0 & 255; return i < 128 ? 128 * j + i : DFF + 128 * j + (i - 128); }
    return n0;
}
__device__ __forceinline__ void transpose_item(const float* W, int K, int Nsrc, int Ndst, bf16* WT, int mode, float* scr, int item, int lane) {
    const int nblk = Ndst / 32, kb = item / nblk, nb = item % nblk, k0 = 64 * kb, n0 = 32 * nb, s0 = src_col(mode, n0);
#pragma unroll 8
    for (int i = 0; i < 32; ++i) { const int kk = 2 * i + (lane >> 5); scr[kk * 33 + (lane & 31)] = W[(size_t)(k0 + kk) * Nsrc + s0 + (lane & 31)]; }
    __builtin_amdgcn_s_waitcnt(0xc07f); asm volatile("" ::: "memory");
    const int c = lane & 7;
#pragma unroll
    for (int j = 0; j < 4; ++j) { const int n = (lane >> 3) + 8 * j; const float* s = scr + (8 * c) * 33 + n;
        u32x4 o; o.x = pk2(s[0 * 33], s[1 * 33]); o.y = pk2(s[2 * 33], s[3 * 33]); o.z = pk2(s[4 * 33], s[5 * 33]); o.w = pk2(s[6 * 33], s[7 * 33]);
        *(u32x4*)(WT + (size_t)(n0 + n) * K + k0 + 8 * c) = o; }
    __builtin_amdgcn_s_waitcnt(0xc07f); asm volatile("" ::: "memory");
}
struct Ptrs {
    const float* in[19]; float* out; unsigned char* ws;
};
constexpr int IT_WIN = (D / 64) * (NP / 32), IT_WM = (1024 / 64) * (D / 32), IT_WO = (D / 64) * (D / 32), IT_WUP = (D / 64) * (NUP / 32), IT_WDN = (DFF / 64) * (D / 32);
constexpr int IT_TOTAL = IT_WIN + 2 * IT_WM + IT_WO + IT_WUP + IT_WDN;


constexpr int NTHR = 512;
constexpr int LDS_BYTES = 147456;

__device__ __forceinline__ void phase_transpose(const Ptrs& p, unsigned char* lds, int wid_) {
    const int TIDX = wid_ * 64 + lane_id();
    const int lane = TIDX & 63, wave = TIDX >> 6;
    float* scr = (float*)lds + wave * 64 * 33;
    const int gw = blockIdx.x * 8 + wave, NGW = gridDim.x * 8;
    for (int it = gw; it < IT_TOTAL; it += NGW) {
        int r = it;
        if (r < IT_WIN) { transpose_item(p.in[2], D, WIN_N, NP, (bf16*)(p.ws + WS_WIN), 1, scr, r, lane); continue; } r -= IT_WIN;
        if (r < IT_WM) { transpose_item(p.in[10], 1024, D, D, (bf16*)(p.ws + WS_WM), 0, scr, r, lane); continue; } r -= IT_WM;
        if (r < IT_WM) { transpose_item(p.in[11], 1024, D, D, (bf16*)(p.ws + WS_WA), 0, scr, r, lane); continue; } r -= IT_WM;
        if (r < IT_WO) { transpose_item(p.in[12], D, D, D, (bf16*)(p.ws + WS_WO), 0, scr, r, lane); continue; } r -= IT_WO;
        if (r < IT_WUP) { transpose_item(p.in[14], D, NUP, NUP, (bf16*)(p.ws + WS_WUP), 2, scr, r, lane); continue; } r -= IT_WUP;
        transpose_item(p.in[17], DFF, D, D, (bf16*)(p.ws + WS_WDN), 0, scr, r, lane);
    }
}

__device__ __forceinline__ void phase_norm_gates(const Ptrs& p, unsigned char* lds, int wid_) {
    const int TIDX = wid_ * 64 + lane_id();
    float* wgs = (float*)lds;
    const float* w_in = p.in[2];
    for (int i = TIDX; i < 2048 * 8; i += NTHR) wgs[i] = w_in[(size_t)(i >> 3) * WIN_N + 3072 + (i & 7)];
    __syncthreads();
    const int lane = TIDX & 63, wave = TIDX >> 6;
    const int gw = blockIdx.x * 8 + wave, NGW = gridDim.x * 8;
    const float* x = p.in[0]; const f32x4* g4 = (const f32x4*)p.in[1];
    bf16* XN = (bf16*)(p.ws + WS_XN); float* LI = (float*)(p.ws + WS_LI); float* LF = (float*)(p.ws + WS_LF);
    for (int row = gw; row < S; row += NGW) {
        const f32x4* xr = (const f32x4*)(x + (size_t)row * D);
        float ss = 0.f;
#pragma unroll
        for (int j = 0; j < 8; ++j) { const f32x4 v = xr[64 * j + lane]; ss += (v.x * v.x + v.y * v.y) + (v.z * v.z + v.w * v.w); }
        const float r = rsqrtf(wave_sum(ss) * (1.f / D) + EPS);
        float d0 = 0.f, d1 = 0.f, d2 = 0.f, d3 = 0.f, d4 = 0.f, d5 = 0.f, d6 = 0.f, d7 = 0.f;
#pragma unroll 1
        for (int j = 0; j < 8; ++j) {
            const f32x4 g = g4[64 * j + lane]; const f32x4 hv = xr[64 * j + lane] * r * g;
            *(u32x2*)(XN + (size_t)row * D + 4 * (64 * j + lane)) = (u32x2){pk2(hv.x, hv.y), pk2(hv.z, hv.w)};
            const float* w = wgs + (size_t)(4 * (64 * j + lane)) * 8;
#pragma unroll
            for (int e = 0; e < 4; ++e) { const f32x4 w0 = *(const f32x4*)(w + 8 * e), w1 = *(const f32x4*)(w + 8 * e + 4);
                const float hh = e == 0 ? hv.x : e == 1 ? hv.y : e == 2 ? hv.z : hv.w;
                d0 += hh * w0.x; d1 += hh * w0.y; d2 += hh * w0.z; d3 += hh * w0.w;
                d4 += hh * w1.x; d5 += hh * w1.y; d6 += hh * w1.z; d7 += hh * w1.w; }
        }
        float dots[8] = {d0, d1, d2, d3, d4, d5, d6, d7};
#pragma unroll
        for (int q = 0; q < 8; ++q) dots[q] = wave_sum(dots[q]);
        if (lane < 4) { float dv = lane == 0 ? dots[0] : lane == 1 ? dots[1] : lane == 2 ? dots[2] : dots[3]; LI[lane * S + row] = dv + p.in[5][lane]; }
        else if (lane < 8) { const int hh = lane - 4; float dv = hh == 0 ? dots[4] : hh == 1 ? dots[5] : hh == 2 ? dots[6] : dots[7];
            const float z = dv + p.in[6][hh]; const float ee = __expf(-fabsf(z)), uu = 1.f + ee; const float l1p = (uu == 1.f) ? ee : __logf(uu) * (ee / (uu - 1.f)); LF[hh * S + row] = fminf(z, 0.f) - l1p; }
    }
}

__device__ __forceinline__ void phase_attn_naive(const Ptrs& p, unsigned char* lds, int wid_) {
    const int TIDX = wid_ * 64 + lane_id();
    const int half = TIDX >> 8, tid = TIDX & 255, lane = tid & 63, wave = tid >> 6;
    float (*sc)[576] = (float (*)[576])(lds + half * 45056);
    float (*qs)[128] = (float (*)[128])(lds + half * 45056 + 36864);
    const bf16* P = (const bf16*)(p.ws + WS_PROJ); bf16* HA = (bf16*)(p.ws + WS_HA);
    for (int vb = 2 * blockIdx.x + half; vb < 4 * NCH * AH; vb += 2 * gridDim.x) {
        const int qg = vb & 3, c = (vb >> 2) & 127, h = vb >> 9;
        const float* bias = p.in[8] + h * 257;
        const int t0 = c * 64 + qg * 16;
        { const int row = tid >> 4, d0 = (tid & 15) * 8; const bf16x8 q = *(const bf16x8*)(P + (size_t)(t0 + row) * NP + C_AQ + h * 128 + d0);
#pragma unroll
          for (int e = 0; e < 8; ++e) qs[row][d0 + e] = bf2f((unsigned short)q[e]); }
        __syncthreads();
        for (int kk = tid; kk < 576; kk += 256) {
            const int kpos = (c - 8) * 64 + kk;
            float acc[16];
#pragma unroll
            for (int i = 0; i < 16; ++i) acc[i] = 0.f;
            if (kpos >= 0) {
                const bf16* kr = P + (size_t)kpos * NP + C_AK + h * 128;
#pragma unroll 1
                for (int d0 = 0; d0 < 16; ++d0) { const bf16x8 kv = *(const bf16x8*)(kr + d0 * 8); float kf[8];
#pragma unroll
                    for (int e = 0; e < 8; ++e) kf[e] = bf2f((unsigned short)kv[e]);
#pragma unroll
                    for (int i = 0; i < 16; ++i)
#pragma unroll
                        for (int e = 0; e < 8; ++e) acc[i] += qs[i][d0 * 8 + e] * kf[e]; }
            }
#pragma unroll
            for (int i = 0; i < 16; ++i) {
                float s = NEGF;
                if (kpos >= 0) { int rel = (512 + qg * 16 + i) - kk; rel = rel < -128 ? -128 : (rel > 128 ? 128 : rel); s = acc[i] * 0.08838834764831845f + bias[rel + 128]; }
                sc[i][kk] = s; }
        }
        __syncthreads();
        for (int rr = 0; rr < 4; ++rr) { const int row = wave * 4 + rr; float m = NEGF;
            for (int i = 0; i < 9; ++i) m = fmaxf(m, sc[row][lane + 64 * i]);
            m = wave_max(m); float sum = 0.f;
            for (int i = 0; i < 9; ++i) { const float e = __expf(sc[row][lane + 64 * i] - m); sc[row][lane + 64 * i] = e; sum += e; }
            sum = wave_sum(sum); const float inv = 1.f / sum;
            for (int i = 0; i < 9; ++i) sc[row][lane + 64 * i] *= inv; }
        __syncthreads();
        { const int d = tid & 127, hf = tid >> 7; float acc[8];
#pragma unroll
          for (int i = 0; i < 8; ++i) acc[i] = 0.f;
#pragma unroll 1
          for (int kk = 0; kk < 576; ++kk) { const int kpos = (c - 8) * 64 + kk; if (kpos < 0) continue;
              const float v = bf2f(P[(size_t)kpos * NP + C_AV + h * 128 + d]);
#pragma unroll
              for (int i = 0; i < 8; ++i) acc[i] += sc[hf * 8 + i][kk] * v; }
#pragma unroll
          for (int i = 0; i < 8; ++i) HA[(size_t)(t0 + hf * 8 + i) * 1024 + h * 128 + d] = (bf16)f2bf(acc[i]); }
        __syncthreads();
    }
}

__device__ __forceinline__ void phase_mlstm_local_naive(const Ptrs& p, unsigned char* lds, int wid_) {
    const int TIDX = wid_ * 64 + lane_id();
    const int half = TIDX >> 8, tid = TIDX & 255;
    float (*ks)[128] = (float (*)[128])(lds + half * 33792);
    float* bsh = (float*)(lds + half * 33792 + 32768); float* wsh = bsh + 64;
    const bf16* P = (const bf16*)(p.ws + WS_PROJ); bf16* QC = (bf16*)(p.ws + WS_QC); bf16* KC = (bf16*)(p.ws + WS_KC);
    const float* cw = p.in[3]; const float* cb = p.in[4];
    const float* LI = (const float*)(p.ws + WS_LI); const float* LF = (const float*)(p.ws + WS_LF);
    for (int vb = 2 * blockIdx.x + half; vb < NCH * MH; vb += 2 * gridDim.x) {
        const int c = vb & 127, h = vb >> 7, t0 = c * 64;
        for (int idx = tid; idx < 2 * 64 * 128; idx += 256) {
            const int which = idx >> 13, rem = idx & 8191, t = rem >> 7, ch = rem & 127, gch = which * 512 + h * 128 + ch;
            float a = cb[gch];
#pragma unroll
            for (int tap = 0; tap < 4; ++tap) { const int tt = t0 + t - 3 + tap; if (tt >= 0) a += cw[tap * 1024 + gch] * bf2f(P[(size_t)tt * NP + gch]); }
            float y = a * sigmoidf_(a);
            if (which == 0) QC[(size_t)(t0 + t) * 512 + h * 128 + ch] = (bf16)f2bf(y);
            else { y *= 0.08838834764831845f; const unsigned short b = (unsigned short)f2bf(y); KC[(size_t)(t0 + t) * 512 + h * 128 + ch] = b; ks[t][ch] = bf2f(b); }
        }
        if (tid == 0) {
            float run = 0.f;
            for (int s = 0; s < 64; ++s) { run += LF[h * S + t0 + s]; bsh[s] = run; }
            const float btot = run; float m = -INFINITY;
            for (int s = 0; s < 64; ++s) { const float wl = btot - bsh[s] + LI[h * S + t0 + s]; wsh[s] = wl; m = fmaxf(m, wl); }
            for (int s = 0; s < 64; ++s) wsh[s] = __expf(wsh[s] - m);
            ((float*)(p.ws + WS_MLOC))[h * 128 + c] = m; ((float*)(p.ws + WS_BTOT))[h * 128 + c] = btot;
        }
        __syncthreads();
        { const int dv = tid; float vw[64];
#pragma unroll
          for (int s = 0; s < 64; ++s) vw[s] = bf2f(P[(size_t)(t0 + s) * NP + C_MV + h * 256 + dv]) * wsh[s];
          float* CL = p.out + ((size_t)(h * 128 + c) * 256 + dv) * 128;
#pragma unroll 1
          for (int dk = 0; dk < 128; ++dk) { float sum = 0.f;
#pragma unroll
              for (int s = 0; s < 64; ++s) sum += vw[s] * ks[s][dk];
              CL[dk] = sum; } }
        if (tid < 128) { float sum = 0.f; for (int s = 0; s < 64; ++s) sum += wsh[s] * ks[s][tid]; ((float*)(p.ws + WS_NLOC))[(h * 128 + c) * 128 + tid] = sum; }
        __syncthreads();
    }
}

__device__ __forceinline__ void phase_scan(const Ptrs& p, int wid_) {
    const int TIDX = wid_ * 64 + lane_id();
    float* CL = p.out; const float* MLOC = (const float*)(p.ws + WS_MLOC); const float* BTOT = (const float*)(p.ws + WS_BTOT);
    float* MPREV = (float*)(p.ws + WS_MPREV); const float* NLOC = (const float*)(p.ws + WS_NLOC); float* NPREV = (float*)(p.ws + WS_NPREV);
    const int tid = TIDX;
    for (int vb = blockIdx.x; vb < 256; vb += gridDim.x) {
        const int h = vb >> 6, rest = ((vb & 63) << 9) + tid;
        const bool nthr = ((vb & 63) == 0) && tid < 128, mthr = ((vb & 63) == 0) && tid == 0;
        float m = NEGF, st = 0.f, nst = 0.f;
#pragma unroll 1
        for (int c0 = 0; c0 < NCH; c0 += 8) {
            float val[8], nv[8];
#pragma unroll
            for (int i = 0; i < 8; ++i) { val[i] = CL[((size_t)(h * 128 + c0 + i) << 15) + rest]; nv[i] = nthr ? NLOC[(h * 128 + c0 + i) * 128 + tid] : 0.f; }
#pragma unroll
            for (int i = 0; i < 8; ++i) { const int c = c0 + i;
                const float bt = BTOT[h * 128 + c], ml = MLOC[h * 128 + c];
                CL[((size_t)(h * 128 + c) << 15) + rest] = st;
                if (nthr) NPREV[(h * 128 + c) * 128 + tid] = nst;
                if (mthr) MPREV[h * 128 + c] = m;
                const float mn = fmaxf(bt + m, ml), a = __expf(bt + m - mn), cl = __expf(ml - mn);
                st = a * st + cl * val[i]; nst = a * nst + cl * nv[i]; m = mn; }
        }
    }
}

__device__ __forceinline__ void phase_mlstm_out_naive(const Ptrs& p, unsigned char* lds0, int wid_) {
    const int TIDX = wid_ * 64 + lane_id();
    const int half = TIDX >> 8, tid = TIDX & 255, lane = tid & 63, wave = tid >> 6;
    unsigned char* lds = lds0 + half * 51200;
    float (*qs)[128] = (float (*)[128])lds;
    float (*ps)[64] = (float (*)[64])(lds + 32768);
    float* bsh = (float*)(lds + 49152); float* lish = bsh + 64; float* ash = lish + 64; float* dsh = ash + 64; float* red = dsh + 64;
    const bf16* P = (const bf16*)(p.ws + WS_PROJ); const bf16* QC = (const bf16*)(p.ws + WS_QC); const bf16* KC = (const bf16*)(p.ws + WS_KC);
    const float* LI = (const float*)(p.ws + WS_LI); const float* LF = (const float*)(p.ws + WS_LF);
    bf16* HM = (bf16*)(p.ws + WS_HM);
    for (int vb = 2 * blockIdx.x + half; vb < NCH * MH; vb += 2 * gridDim.x) {
        const int c = vb & 127, h = vb >> 7, t0 = c * 64;
        for (int i = tid; i < 64 * 16; i += 256) { const int t = i >> 4, d0 = (i & 15) * 8; const bf16x8 q = *(const bf16x8*)(QC + (size_t)(t0 + t) * 512 + h * 128 + d0);
#pragma unroll
            for (int e = 0; e < 8; ++e) qs[t][d0 + e] = bf2f((unsigned short)q[e]); }
        if (tid == 0) { float run = 0.f; for (int s = 0; s < 64; ++s) { run += LF[h * S + t0 + s]; bsh[s] = run; lish[s] = LI[h * S + t0 + s]; } }
        __syncthreads();
        const float mprev = ((const float*)(p.ws + WS_MPREV))[h * 128 + c];
        { const int t = tid >> 2, sg = tid & 3; float dot[16]; float mt = bsh[t] + mprev;
#pragma unroll
          for (int si = 0; si < 16; ++si) { const int s = sg * 16 + si; float a = 0.f; const bf16* kr = KC + (size_t)(t0 + s) * 512 + h * 128;
#pragma unroll 1
              for (int d0 = 0; d0 < 16; ++d0) { const bf16x8 kv = *(const bf16x8*)(kr + d0 * 8);
#pragma unroll
                  for (int e = 0; e < 8; ++e) a += qs[t][d0 * 8 + e] * bf2f((unsigned short)kv[e]); }
              dot[si] = a; if (s <= t) mt = fmaxf(mt, bsh[t] - bsh[s] + lish[s]); }
          mt = fmaxf(mt, __shfl_xor(mt, 1)); mt = fmaxf(mt, __shfl_xor(mt, 2));
          float psum = 0.f;
#pragma unroll
          for (int si = 0; si < 16; ++si) { const int s = sg * 16 + si; const float pv = (s <= t) ? __expf(bsh[t] - bsh[s] + lish[s] - mt) * dot[si] : 0.f; ps[t][s] = pv; psum += pv; }
          psum += __shfl_xor(psum, 1); psum += __shfl_xor(psum, 2);
          const float* np = (const float*)(p.ws + WS_NPREV) + (h * 128 + c) * 128; float qn = 0.f;
          for (int dk = sg * 32; dk < sg * 32 + 32; ++dk) qn += qs[t][dk] * np[dk];
          qn += __shfl_xor(qn, 1); qn += __shfl_xor(qn, 2);
          const float ai = __expf(bsh[t] + mprev - mt), den = psum + ai * qn;
          if (sg == 0) { ash[t] = ai; dsh[t] = fmaxf(fabsf(den), __expf(-mt)); } }
        __syncthreads();
        const int dv = tid;
        const float mn = p.in[7][h * 256 + dv];
        const float* cp = p.out + ((size_t)(h * 128 + c) * 256 + dv) * 128;
#pragma unroll 1
        for (int th = 0; th < 4; ++th) {
            float ainter[16], aintra[16];
#pragma unroll
            for (int t = 0; t < 16; ++t) { ainter[t] = 0.f; aintra[t] = 0.f; }
#pragma unroll 1
            for (int dk0 = 0; dk0 < 128; dk0 += 4) { const f32x4 c4 = *(const f32x4*)(cp + dk0);
#pragma unroll
                for (int t = 0; t < 16; ++t) { const f32x4 q4 = *(const f32x4*)(&qs[th * 16 + t][dk0]); ainter[t] += (q4.x * c4.x + q4.y * c4.y) + (q4.z * c4.z + q4.w * c4.w); } }
#pragma unroll 1
            for (int s0 = 0; s0 < 64; s0 += 4) { float vv[4];
#pragma unroll
                for (int e = 0; e < 4; ++e) vv[e] = bf2f(P[(size_t)(t0 + s0 + e) * NP + C_MV + h * 256 + dv]);
#pragma unroll
                for (int t = 0; t < 16; ++t) { const f32x4 p4 = *(const f32x4*)(&ps[th * 16 + t][s0]); aintra[t] += (p4.x * vv[0] + p4.y * vv[1]) + (p4.z * vv[2] + p4.w * vv[3]); } }
            float hv[16];
#pragma unroll
            for (int t = 0; t < 16; ++t) { hv[t] = (aintra[t] + ash[th * 16 + t] * ainter[t]) / dsh[th * 16 + t]; const float ss = wave_sum(hv[t] * hv[t]); if (lane == 0) red[wave * 64 + th * 16 + t] = ss; }
            __syncthreads();
#pragma unroll
            for (int t = 0; t < 16; ++t) { const int tt = th * 16 + t; const float ss = (red[tt] + red[64 + tt]) + (red[128 + tt] + red[192 + tt]); const float r = rsqrtf(ss * (1.f / 256.f) + EPS);
                const float o = bf2f(P[(size_t)(t0 + tt) * NP + C_MO + h * 256 + dv]);
                HM[(size_t)(t0 + tt) * 1024 + h * 256 + dv] = (bf16)f2bf(hv[t] * r * mn * sigmoidf_(o)); }
        }
        __syncthreads();
    }
}

__device__ __forceinline__ void phase_rowstat(const Ptrs& p, int wid_) {
    const int TIDX = wid_ * 64 + lane_id();
    float* RS2 = (float*)(p.ws + WS_RS2); const float* slab = (const float*)(p.ws + WS_SLAB);
    for (int row = blockIdx.x * NTHR + TIDX; row < S; row += gridDim.x * NTHR) { float ss = 0.f;
#pragma unroll
        for (int i = 0; i < 32; ++i) ss += slab[(size_t)i * S + row];
        RS2[row] = rsqrtf(ss * (1.f / D) + EPS); }
}

__device__ __forceinline__ void phase_ffn_conv(const Ptrs& p, int wid_) {
    const int TIDX = wid_ * 64 + lane_id();
    const int lane = TIDX & 63, gw = blockIdx.x * 8 + (TIDX >> 6), NGW = gridDim.x * 8;
    const bf16* U = (const bf16*)(p.ws + WS_U); bf16* ACT = (bf16*)(p.ws + WS_ACT); const float* RS2 = (const float*)(p.ws + WS_RS2);
    const float* cw = p.in[15]; const float* cb = p.in[16];
    constexpr int NCB = DFF / 512, NRB = S / 16;
    for (int unit = gw; unit < NCB * NRB; unit += NGW) {
        const int cbk = unit % NCB, rb = unit / NCB, ch0 = cbk * 512 + lane * 8, j = ch0 >> 7, i0 = ch0 & 127, gcol = 256 * j + i0, vcol = gcol + 128, r0 = rb * 16;
        float w0[8], w1[8], w2[8], bb[8], gm2[8], gm1[8];
#pragma unroll
        for (int e = 0; e < 8; ++e) { w0[e] = cw[ch0 + e]; w1[e] = cw[DFF + ch0 + e]; w2[e] = cw[2 * DFF + ch0 + e]; bb[e] = cb[ch0 + e]; gm2[e] = 0.f; gm1[e] = 0.f; }
        if (r0 >= 2) { const float ra = RS2[r0 - 2], rbv = RS2[r0 - 1];
            const bf16x8 a = *(const bf16x8*)(U + (size_t)(r0 - 2) * NUP + gcol), b = *(const bf16x8*)(U + (size_t)(r0 - 1) * NUP + gcol);
#pragma unroll
            for (int e = 0; e < 8; ++e) { gm2[e] = ra * bf2f((unsigned short)a[e]); gm1[e] = rbv * bf2f((unsigned short)b[e]); } }
#pragma unroll 1
        for (int t = r0; t < r0 + 16; ++t) { const float r = RS2[t];
            const bf16x8 g = *(const bf16x8*)(U + (size_t)t * NUP + gcol), v = *(const bf16x8*)(U + (size_t)t * NUP + vcol); float o[8];
#pragma unroll
            for (int e = 0; e < 8; ++e) { const float g0 = r * bf2f((unsigned short)g[e]); const float cv = bb[e] + w0[e] * gm2[e] + w1[e] * gm1[e] + w2[e] * g0;
                o[e] = cv * sigmoidf_(cv) * (r * bf2f((unsigned short)v[e])); gm2[e] = gm1[e]; gm1[e] = g0; }
            *(u32x4*)(ACT + (size_t)t * DFF + ch0) = (u32x4){pk2(o[0], o[1]), pk2(o[2], o[3]), pk2(o[4], o[5]), pk2(o[6], o[7])}; }
    }
}

__device__ __forceinline__ void phase_final_norm(const Ptrs& p, int wid_) {
    const int TIDX = wid_ * 64 + lane_id();
    const int lane = TIDX & 63, gw = blockIdx.x * 8 + (TIDX >> 6), NGW = gridDim.x * 8;
    const f32x4* g4 = (const f32x4*)p.in[18];
    for (int row = gw; row < S; row += NGW) { f32x4* xr = (f32x4*)(p.out + (size_t)row * D); f32x4 v[8]; float ss = 0.f;
#pragma unroll
        for (int j = 0; j < 8; ++j) { v[j] = xr[64 * j + lane]; ss += (v[j].x * v[j].x + v[j].y * v[j].y) + (v[j].z * v[j].z + v[j].w * v[j].w); }
        const float r = rsqrtf(wave_sum(ss) * (1.f / D) + EPS);
#pragma unroll
        for (int j = 0; j < 8; ++j) xr[64 * j + lane] = v[j] * r * g4[64 * j + lane]; }
}


namespace pg8 {
#define PG8_LAS __attribute__((address_space(3)))
typedef unsigned short bf16_t;
constexpr int BM = 256, BK = 64, HALF = 128, HTB = HALF * BK * 2  , STAGE_BYTES = 8 * HTB, NXCD = 8, WGM = 8;
__host__ __device__ __forceinline__ int lds_byte(int r, int c) { const int st = (r >> 4) * 2 + (c >> 5), rr = r & 15, cc = c & 31, ob = rr * 64 + cc * 2; return st * 1024 + (ob ^ (((ob >> 9) & 1) << 5)); }
__host__ __device__ __forceinline__ void stage_rc(int b, int& R, int& C) { const int st = b / 1024, sb = b % 1024, swz = sb ^ (((sb >> 9) & 1) << 5); R = (st >> 1) * 16 + swz / 64; C = (st & 1) * 32 + (swz % 64) / 2; }
__host__ __device__ __forceinline__ int perm32(int rho) { const int n = rho >> 4, i = rho & 15; return 8 * (i >> 2) + 4 * n + (i & 3); }

struct Unit { int pm, pn, seg; };
struct Gemm { const bf16_t* A; const bf16_t* Bt; const bf16_t* A1; const bf16_t* Bt1; int K;
    __device__ __forceinline__ const char* aptr(const Unit& u) const { return (const char*)(u.seg ? A1 : A) + (size_t)u.pm * BM * K * 2; }
    __device__ __forceinline__ const char* bptr(const Unit& u) const { return (const char*)(u.seg ? Bt1 : Bt) + (size_t)u.pn * BM * K * 2; } };

struct StaticOrder {
    int nM, nN, nwg, G, c, nseg;
    __host__ __device__ void init(int M, int N, int G_, int c_, int nseg_ = 1) { nM = M / BM; nN = N / BM; nwg = nM * nN; G = G_; c = c_; nseg = nseg_; }
    __host__ __device__ bool next(int i, Unit& u) const {
        const int it = i / nseg; u.seg = i - it * nseg;
        const long L = (long)it * G + c; if (L >= nwg) return false;
        int wgid = (int)L; { const int q = nwg / NXCD, r = nwg % NXCD, xcd = wgid % NXCD, off = wgid / NXCD; wgid = (xcd < r ? xcd * (q + 1) : r * (q + 1) + (xcd - r) * q) + off; }
        const int nig = WGM * nN, gid = wgid / nig, fm = gid * WGM, gsz = (nM - fm) < WGM ? (nM - fm) : WGM;
        u.pm = fm + ((wgid % nig) % gsz); u.pn = (wgid % nig) / gsz; return true;
    }
    __device__ __forceinline__ void a_ready(const Unit&) const {}
    __device__ __forceinline__ void done(const Unit&) const {}
};
__device__ __forceinline__ unsigned cvt_pk_bf16(float lo, float hi) { unsigned r; asm volatile("v_cvt_pk_bf16_f32 %0, %1, %2" : "=v"(r) : "v"(lo), "v"(hi)); return r; }

struct EpiBf16 {
    static constexpr bool PERM = true, AFTER_DRAIN = false;
    bf16_t* O; int ldc;
    __device__ __forceinline__ void operator()(f32x4 (&acc)[2][2][4][2], const Unit& u, int wr, int wc, int fr, int fq) const {
        const int row0 = u.pm * BM + wr * 64 + fr, col0 = u.pn * BM + wc * 32 + 8 * fq;
#pragma unroll
        for (int ai = 0; ai < 2; ++ai)
#pragma unroll
            for (int m = 0; m < 4; ++m) { bf16_t* rowp = O + (size_t)(row0 + ai * HALF + m * 16) * ldc + col0;
#pragma unroll
                for (int bj = 0; bj < 2; ++bj) { const f32x4 v0 = acc[ai][bj][m][0], v1 = acc[ai][bj][m][1];
                    u32x4 w; w.x = cvt_pk_bf16(v0[0], v0[1]); w.y = cvt_pk_bf16(v0[2], v0[3]); w.z = cvt_pk_bf16(v1[0], v1[1]); w.w = cvt_pk_bf16(v1[2], v1[3]);
                    *(u32x4*)(rowp + bj * HALF) = w; } }
    }
};

struct EpiResid1 {
    static constexpr bool PERM = true, AFTER_DRAIN = false;
    const float* x; float* out; bf16_t* A2; const float* g; float* slab;
    __device__ __forceinline__ void operator()(f32x4 (&acc)[2][2][4][2], const Unit& u, int wr, int wc, int fr, int fq) const {
        const int row0 = u.pm * BM + wr * 64 + fr, col0 = u.pn * BM + wc * 32 + 8 * fq;
        f32x4 gv[2][2];
#pragma unroll
        for (int bj = 0; bj < 2; ++bj)
#pragma unroll
            for (int n = 0; n < 2; ++n) gv[bj][n] = *(const f32x4*)(g + col0 + bj * HALF + 4 * n);
#pragma unroll
        for (int ai = 0; ai < 2; ++ai)
#pragma unroll
            for (int m = 0; m < 4; ++m) { const int row = row0 + ai * HALF + m * 16; const size_t off = (size_t)row * D + col0; float ss = 0.f;
#pragma unroll
                for (int bj = 0; bj < 2; ++bj) {
                    const f32x4 a0 = *(const f32x4*)(x + off + bj * HALF) + acc[ai][bj][m][0], a1 = *(const f32x4*)(x + off + bj * HALF + 4) + acc[ai][bj][m][1];
                    *(f32x4*)(out + off + bj * HALF) = a0; *(f32x4*)(out + off + bj * HALF + 4) = a1;
                    ss += (a0[0] * a0[0] + a0[1] * a0[1]) + (a0[2] * a0[2] + a0[3] * a0[3]) + (a1[0] * a1[0] + a1[1] * a1[1]) + (a1[2] * a1[2] + a1[3] * a1[3]);
                    const f32x4 b0 = a0 * gv[bj][0], b1 = a1 * gv[bj][1];
                    u32x4 w; w.x = cvt_pk_bf16(b0[0], b0[1]); w.y = cvt_pk_bf16(b0[2], b0[3]); w.z = cvt_pk_bf16(b1[0], b1[1]); w.w = cvt_pk_bf16(b1[2], b1[3]);
                    *(u32x4*)(A2 + off + bj * HALF) = w; }
                ss += __shfl_xor(ss, 16); ss += __shfl_xor(ss, 32);
                if (fq == 0) slab[(size_t)(u.pn * 4 + wc) * S + row] = ss; }
    }
};
struct EpiResid2 {
    static constexpr bool PERM = false, AFTER_DRAIN = false;
    float* out;
    __device__ __forceinline__ void operator()(f32x4 (&acc)[2][2][4][2], const Unit& u, int wr, int wc, int fr, int fq) const {
        const int row0 = u.pm * BM + wr * 64 + fr, col0 = u.pn * BM + wc * 32 + 4 * fq;
#pragma unroll
        for (int ai = 0; ai < 2; ++ai)
#pragma unroll
            for (int m = 0; m < 4; ++m) { const size_t off = (size_t)(row0 + ai * HALF + m * 16) * D + col0;
#pragma unroll
                for (int bj = 0; bj < 2; ++bj)
#pragma unroll
                    for (int n = 0; n < 2; ++n) { float* q = out + off + bj * HALF + n * 16; *(f32x4*)q = *(const f32x4*)q + acc[ai][bj][m][n]; } }
    }
};
struct EpiMerge {
    static constexpr bool PERM = true, AFTER_DRAIN = false;
    const bf16_t* P; const float* gb; bf16_t* O;
    __device__ __forceinline__ void operator()(f32x4 (&acc)[2][2][4][2], const Unit& u, int wr, int wc, int fr, int fq) const {
        const int row0 = u.pm * BM + wr * 64 + fr, col0 = u.pn * BM + wc * 32 + 8 * fq;
        f32x4 bm[2][2], ba[2][2];
#pragma unroll
        for (int bj = 0; bj < 2; ++bj)
#pragma unroll
            for (int n = 0; n < 2; ++n) { bm[bj][n] = *(const f32x4*)(gb + col0 + bj * HALF + 4 * n); ba[bj][n] = *(const f32x4*)(gb + D + col0 + bj * HALF + 4 * n); }
        const bool mid = (u.seg == 0);
#pragma unroll
        for (int ai = 0; ai < 2; ++ai)
#pragma unroll
            for (int m = 0; m < 4; ++m) { const int row = row0 + ai * HALF + m * 16; const bf16_t* prow = P + (size_t)row * NP + col0;
#pragma unroll
                for (int bj = 0; bj < 2; ++bj) {
                    const bf16x8 ga8 = *(const bf16x8*)(prow + C_GA + bj * HALF);
                    float ea[8];
#pragma unroll
                    for (int e = 0; e < 8; ++e) ea[e] = __expf(fminf(-(bf2f((unsigned short)ga8[e]) + ba[bj][e >> 2][e & 3]), 80.f));
                    if (mid) {
                        const bf16x8 gm8 = *(const bf16x8*)(prow + C_GM + bj * HALF);
#pragma unroll
                        for (int e = 0; e < 8; ++e) { const float em = __expf(fminf(-(bf2f((unsigned short)gm8[e]) + bm[bj][e >> 2][e & 3]), 80.f));
                            acc[ai][bj][m][e >> 2][e & 3] *= (1.f + ea[e]) / (1.f + em); }
                    } else {
                        float v[8];
#pragma unroll
                        for (int e = 0; e < 8; ++e) v[e] = acc[ai][bj][m][e >> 2][e & 3] / (1.f + ea[e]);
                        u32x4 w; w.x = cvt_pk_bf16(v[0], v[1]); w.y = cvt_pk_bf16(v[2], v[3]); w.z = cvt_pk_bf16(v[4], v[5]); w.w = cvt_pk_bf16(v[6], v[7]);
                        *(u32x4*)(O + (size_t)row * D + col0 + bj * HALF) = w; } } }
    }
};
template <class Epi, class Sched, bool ALIGN_EPI = false, bool SP2 = false>
__device__ __forceinline__ void gemm_phase(PG8_LAS unsigned char* lds, const Gemm g, const Sched& S, const Epi& E, int wid_) {
    const int wid = wid_, lane = lane_id(), tid = wid * 64 + lane, wr = wid >> 2, wc = wid & 3, fr = lane & 15, fq = lane >> 4;
    const int K = g.K, nt = K / BK;
    unsigned voffA[2], voffB[2];
#pragma unroll
    for (int i = 0; i < 2; ++i) { int R, C; stage_rc(tid * 16 + i * 8192, R, C); const int Rb = Epi::PERM ? ((R & ~31) + perm32(R & 31)) : R;
        voffA[i] = (unsigned)(R * K + C) * 2u; voffB[i] = (unsigned)(Rb * K + C) * 2u; }
    const size_t kstep = (size_t)(BK * 2);
    const size_t hstep = (size_t)HALF * K * 2;
        const unsigned ldsw = (unsigned)wid * 1024u;
    const int aoff = lds_byte(wr * 64 + fr, fq * 8), boff = lds_byte(wc * 32 + fr, fq * 8);
#define PG8_SA(b, h) (((b) * 2 + (h)) * HTB)
#define PG8_SB(b, h) ((4 + (b) * 2 + (h)) * HTB)
#define PG8_STAGE(bufoff, gbase, voff) do { _Pragma("unroll") for (int _i = 0; _i < 2; ++_i) \
        __builtin_amdgcn_global_load_lds((const unsigned*)((const char*)(gbase) + (voff)[_i]), (PG8_LAS unsigned*)(lds + (bufoff) + ldsw + _i * 8192), 16, 0, 0); } while (0)
#define PG8_LDA(dst, b, h) do { _Pragma("unroll") for (int m = 0; m < 4; ++m) _Pragma("unroll") for (int k = 0; k < 2; ++k) dst[m][k] = *(const PG8_LAS bf16x8*)(lds + PG8_SA(b, h) + aoff + m * 2048 + k * 1024); } while (0)
#define PG8_LDB(dst, b, h) do { _Pragma("unroll") for (int n = 0; n < 2; ++n) _Pragma("unroll") for (int k = 0; k < 2; ++k) dst[n][k] = *(const PG8_LAS bf16x8*)(lds + PG8_SB(b, h) + boff + n * 2048 + k * 1024); } while (0)
#define PG8_MMA(ai, bj, At, Bt) do { __builtin_amdgcn_s_setprio(1); _Pragma("unroll") for (int m = 0; m < 4; ++m) _Pragma("unroll") for (int n = 0; n < 2; ++n) _Pragma("unroll") for (int k = 0; k < 2; ++k) \
        acc[ai][bj][m][n] = __builtin_amdgcn_mfma_f32_16x16x32_bf16(Bt[n][k], At[m][k], acc[ai][bj][m][n], 0, 0, 0); __builtin_amdgcn_s_setprio(0); } while (0)
#define PG8_WAIT_V(n) asm volatile("s_waitcnt vmcnt(" #n ")" ::: "memory")
#define PG8_WAIT_L(n) asm volatile("s_waitcnt lgkmcnt(" #n ")" ::: "memory")
#define PG8_BAR __builtin_amdgcn_s_barrier()
#define PG8_SCHED __builtin_amdgcn_sched_barrier(0)
    Unit cur, nxt; int ui = 0;
    if (!S.next(0, cur)) return;
    f32x4 acc[2][2][4][2];
#pragma unroll
    for (int a = 0; a < 2; ++a)
#pragma unroll
        for (int b = 0; b < 2; ++b)
#pragma unroll
            for (int m = 0; m < 4; ++m)
#pragma unroll
                for (int n = 0; n < 2; ++n) acc[a][b][m][n] = (f32x4){0.f, 0.f, 0.f, 0.f};
    bf16x8 At[4][2], B0[2][2], B1[2][2];
    const char* cA = g.aptr(cur); const char* cB = g.bptr(cur);
    S.a_ready(cur);
    if constexpr (SP2) {
        PG8_STAGE(PG8_SB(0, 0), cB, voffB); PG8_STAGE(PG8_SB(0, 1), cB + hstep, voffB); PG8_STAGE(PG8_SA(0, 0), cA, voffA); PG8_STAGE(PG8_SA(0, 1), cA + hstep, voffA);
        if (wr == 1) PG8_BAR;
        PG8_WAIT_V(2); PG8_BAR;
        PG8_STAGE(PG8_SB(1, 0), cB + kstep, voffB); PG8_STAGE(PG8_SA(1, 0), cA + kstep, voffA); PG8_STAGE(PG8_SB(1, 1), cB + hstep + kstep, voffB);
        PG8_WAIT_V(6); PG8_BAR;
    } else {
        PG8_STAGE(PG8_SB(0, 0), cB, voffB); PG8_STAGE(PG8_SA(0, 0), cA, voffA); PG8_STAGE(PG8_SB(0, 1), cB + hstep, voffB); PG8_STAGE(PG8_SA(0, 1), cA + hstep, voffA);
        if (wr == 1) PG8_BAR;
        PG8_WAIT_V(4); PG8_BAR;
        PG8_STAGE(PG8_SB(1, 0), cB + kstep, voffB); PG8_STAGE(PG8_SA(1, 0), cA + kstep, voffA); PG8_STAGE(PG8_SB(1, 1), cB + hstep + kstep, voffB);
        PG8_WAIT_V(6); PG8_BAR;
    }
    for (;;) {
        const bool has_next = S.next(ui + 1, nxt);
        const char* nA = has_next ? g.aptr(nxt) : cA; const char* nB = has_next ? g.bptr(nxt) : cB;
        for (int t = 0; t < nt; t += 2) {
            const bool last = (t == nt - 2);
            const char* a1 = cA + (size_t)(t + 1) * kstep;
            const char* a2 = last ? nA : cA + (size_t)(t + 2) * kstep; const char* b2 = last ? nB : cB + (size_t)(t + 2) * kstep;
            const char* a3 = a2 + kstep; const char* b3 = b2 + kstep;
            if (last && has_next) S.a_ready(nxt);
            if constexpr (SP2) {
            PG8_LDB(B0, 0, 0); PG8_LDB(B1, 0, 1); PG8_SCHED; PG8_LDA(At, 0, 0); PG8_STAGE(PG8_SA(1, 1), a1 + hstep, voffA);
            PG8_WAIT_V(8); PG8_WAIT_L(0); PG8_BAR; PG8_MMA(0, 0, At, B0); PG8_MMA(0, 1, At, B1); PG8_BAR; PG8_SCHED;
            PG8_LDA(At, 0, 1); PG8_STAGE(PG8_SB(0, 0), b2, voffB); PG8_STAGE(PG8_SB(0, 1), b2 + hstep, voffB); PG8_STAGE(PG8_SA(0, 0), a2, voffA);
            PG8_WAIT_V(8); PG8_WAIT_L(0); PG8_BAR; PG8_MMA(1, 0, At, B0); PG8_MMA(1, 1, At, B1); PG8_BAR; PG8_SCHED;
            PG8_LDB(B0, 1, 0); PG8_LDB(B1, 1, 1); PG8_SCHED; PG8_LDA(At, 1, 0); PG8_STAGE(PG8_SA(0, 1), a2 + hstep, voffA);
            PG8_WAIT_V(8); PG8_WAIT_L(0); PG8_BAR; PG8_MMA(0, 0, At, B0); PG8_MMA(0, 1, At, B1); PG8_BAR; PG8_SCHED;
            PG8_LDA(At, 1, 1); PG8_STAGE(PG8_SB(1, 0), b3, voffB); PG8_STAGE(PG8_SB(1, 1), b3 + hstep, voffB); PG8_STAGE(PG8_SA(1, 0), a3, voffA);
            PG8_WAIT_V(8); PG8_WAIT_L(0); PG8_BAR; PG8_MMA(1, 0, At, B0); PG8_MMA(1, 1, At, B1); PG8_BAR; PG8_SCHED;
            } else {
            PG8_LDB(B0, 0, 0); PG8_SCHED; PG8_LDA(At, 0, 0); PG8_STAGE(PG8_SA(1, 1), a1 + hstep, voffA);
            PG8_WAIT_L(8); PG8_BAR; PG8_WAIT_L(0); PG8_MMA(0, 0, At, B0); PG8_BAR; PG8_SCHED;
            PG8_LDB(B1, 0, 1); PG8_STAGE(PG8_SB(0, 0), b2, voffB);
            PG8_BAR; PG8_WAIT_L(0); PG8_MMA(0, 1, At, B1); PG8_BAR;
            PG8_LDA(At, 0, 1); PG8_STAGE(PG8_SA(0, 0), a2, voffA);
            PG8_BAR; PG8_WAIT_L(0); PG8_MMA(1, 0, At, B0); PG8_BAR; PG8_SCHED;
            PG8_STAGE(PG8_SB(0, 1), b2 + hstep, voffB);
            PG8_WAIT_V(6); PG8_BAR; PG8_MMA(1, 1, At, B1); PG8_BAR;
            PG8_LDB(B0, 1, 0); PG8_SCHED; PG8_LDA(At, 1, 0); PG8_STAGE(PG8_SA(0, 1), a2 + hstep, voffA);
            PG8_WAIT_L(8); PG8_BAR; PG8_WAIT_L(0); PG8_MMA(0, 0, At, B0); PG8_BAR; PG8_SCHED;
            PG8_LDB(B1, 1, 1); PG8_STAGE(PG8_SB(1, 0), b3, voffB);
            PG8_BAR; PG8_WAIT_L(0); PG8_MMA(0, 1, At, B1); PG8_BAR;
            PG8_LDA(At, 1, 1); PG8_STAGE(PG8_SA(1, 0), a3, voffA);
            PG8_BAR; PG8_WAIT_L(0); PG8_MMA(1, 0, At, B0); PG8_BAR; PG8_SCHED;
            PG8_STAGE(PG8_SB(1, 1), b3 + hstep, voffB);
            PG8_WAIT_V(6); PG8_BAR; PG8_MMA(1, 1, At, B1); PG8_BAR;
            }
        }
        if constexpr (ALIGN_EPI) { if (wr == 0) PG8_BAR; }
        if constexpr (!Epi::AFTER_DRAIN) { E(acc, cur, wr, wc, fr, fq); S.done(cur); }
        if (!has_next) break;
        if (nxt.seg == 0)
#pragma unroll
        for (int a = 0; a < 2; ++a)
#pragma unroll
            for (int b = 0; b < 2; ++b)
#pragma unroll
                for (int m = 0; m < 4; ++m)
#pragma unroll
                    for (int n = 0; n < 2; ++n) acc[a][b][m][n] = (f32x4){0.f, 0.f, 0.f, 0.f};
        cur = nxt; cA = nA; cB = nB; ++ui;
        if constexpr (ALIGN_EPI) { if (wr == 1) PG8_BAR; }
    }
    PG8_WAIT_V(0);
    if constexpr (!ALIGN_EPI) { if (wr == 0) PG8_BAR; }
    PG8_BAR;
    if constexpr (Epi::AFTER_DRAIN) { E.fused(acc, cur, wr, wc, fr, fq, lds, wid, lane); S.done(cur); }
#undef PG8_SA
#undef PG8_SB
#undef PG8_STAGE
#undef PG8_LDA
#undef PG8_LDB
#undef PG8_MMA
#undef PG8_WAIT_V
#undef PG8_WAIT_L
#undef PG8_BAR
#undef PG8_SCHED
}
}


namespace att {
using s16x4 = __attribute__((ext_vector_type(4))) short;
using f32x16 = __attribute__((ext_vector_type(16))) float;
#define KSWZ(row, colB) ((row) * 256 + ((colB) ^ (((row) & 7) << 4)))
#define SBAR() __builtin_amdgcn_sched_barrier(0)
__device__ __forceinline__ int crow(int r, int hi) { return (r & 3) + 8 * (r >> 2) + 4 * hi; }
__device__ __forceinline__ unsigned cvtpk(float lo, float hi) { unsigned r; asm volatile("v_cvt_pk_bf16_f32 %0, %1, %2" : "=v"(r) : "v"(lo), "v"(hi)); return r; }
__device__ __forceinline__ int v_st(int k, int c) { const int kk = (k & ~0xC) | ((k & 4) << 1) | ((k & 8) >> 1); return ((kk >> 3) * 4 + (c >> 5)) * 512 + ((kk & 7) * 32 + (c & 31)) * 2; }
__device__ __forceinline__ int v_rd_base(int lane) { return ((lane & 3) << 3) | (((lane >> 2) & 3) << 6) | (((lane >> 4) & 1) << 5) | (((lane >> 5) & 1) << 8); }
constexpr int v_rd_off(int d0, int ks, int half) { return d0 * 512 + ks * 4096 + half * 2048; }
template <int OFF> __device__ __forceinline__ s16x4 tr_read(int vb) { s16x4 r; asm volatile("ds_read_b64_tr_b16 %0, %1 offset:%2" : "=&v"(r) : "v"(vb), "i"(OFF) : "memory"); return r; }
#define ATT_PK(L, H) (bf16x8){L[0], L[1], L[2], L[3], H[0], H[1], H[2], H[3]}
template <int D0> __device__ __forceinline__ void frag4(int vb, bf16x8& f0, bf16x8& f1, bf16x8& f2, bf16x8& f3) {
    const s16x4 l0 = tr_read<v_rd_off(D0, 0, 0)>(vb), h0 = tr_read<v_rd_off(D0, 0, 1)>(vb), l1 = tr_read<v_rd_off(D0, 1, 0)>(vb), h1 = tr_read<v_rd_off(D0, 1, 1)>(vb);
    const s16x4 l2 = tr_read<v_rd_off(D0, 2, 0)>(vb), h2 = tr_read<v_rd_off(D0, 2, 1)>(vb), l3 = tr_read<v_rd_off(D0, 3, 0)>(vb), h3 = tr_read<v_rd_off(D0, 3, 1)>(vb);
    asm volatile("s_waitcnt lgkmcnt(0)" ::: "memory"); SBAR();
    f0 = ATT_PK(l0, h0); f1 = ATT_PK(l1, h1); f2 = ATT_PK(l2, h2); f3 = ATT_PK(l3, h3);
}
template <int D0> __device__ __forceinline__ void pv_one(f32x16& od, int vb, bf16x8 pa0, bf16x8 pa1, bf16x8 pa2, bf16x8 pa3) {
    bf16x8 f0, f1, f2, f3; frag4<D0>(vb, f0, f1, f2, f3);
    od = __builtin_amdgcn_mfma_f32_32x32x16_bf16(pa0, f0, od, 0, 0, 0);
    od = __builtin_amdgcn_mfma_f32_32x32x16_bf16(pa1, f1, od, 0, 0, 0);
    od = __builtin_amdgcn_mfma_f32_32x32x16_bf16(pa2, f2, od, 0, 0, 0);
    od = __builtin_amdgcn_mfma_f32_32x32x16_bf16(pa3, f3, od, 0, 0, 0);
}
__device__ __forceinline__ void qkt(f32x16& p0, f32x16& p1, const char* Ks, const bf16x8* qr, int r32, int hi) {
#pragma unroll
    for (int d0 = 0; d0 < 8; ++d0) { const int cb = (d0 * 16 + hi * 8) * 2;
        const bf16x8 b0 = *reinterpret_cast<const bf16x8*>(Ks + KSWZ(r32, cb));
        const bf16x8 b1 = *reinterpret_cast<const bf16x8*>(Ks + KSWZ(32 + r32, cb));
        p0 = __builtin_amdgcn_mfma_f32_32x32x16_bf16(b0, qr[d0], p0, 0, 0, 0);
        p1 = __builtin_amdgcn_mfma_f32_32x32x16_bf16(b1, qr[d0], p1, 0, 0, 0); }
}
__device__ __forceinline__ void pack_p(const f32x16& p0, const f32x16& p1, bf16x8& pa0, bf16x8& pa1, bf16x8& pa2, bf16x8& pa3) {
#define ATT_PK4(P, BASE, OUT) do { unsigned a0 = cvtpk(P[BASE + 0], P[BASE + 1]), a1 = cvtpk(P[BASE + 2], P[BASE + 3]);   \
    unsigned b0 = cvtpk(P[BASE + 4], P[BASE + 5]), b1 = cvtpk(P[BASE + 6], P[BASE + 7]);                              \
    auto r0 = __builtin_amdgcn_permlane32_swap(a0, b0, false, false); auto r1 = __builtin_amdgcn_permlane32_swap(a1, b1, false, false); \
    u32x4 w = {r0[0], r1[0], r0[1], r1[1]}; OUT = *reinterpret_cast<bf16x8*>(&w); } while (0)
    ATT_PK4(p0, 0, pa0); ATT_PK4(p0, 8, pa1); ATT_PK4(p1, 0, pa2); ATT_PK4(p1, 8, pa3);
#undef ATT_PK4
}
__device__ __forceinline__ float swap_max(float v) { auto rr = __builtin_amdgcn_permlane32_swap(__float_as_uint(v), __float_as_uint(v), false, false); return fmaxf(__uint_as_float(rr[0]), __uint_as_float(rr[1])); }
__device__ __forceinline__ float swap_add(float v) { auto rr = __builtin_amdgcn_permlane32_swap(__float_as_uint(v), __float_as_uint(v), false, false); return __uint_as_float(rr[0]) + __uint_as_float(rr[1]); }

constexpr float SCALE = 0.088388347648318440f, SQ = 11.313708498984761f, CL2 = SCALE * 1.4426950408889634f;
__device__ __forceinline__ void phase_attn(const Ptrs& p, unsigned char* lds, int wid_) {
    const int wid = wid_, lane = lane_id(), tid = wid * 64 + lane, r32 = lane & 31, hi = lane >> 5;
    char* V_lds = (char*)lds; char* K_lds = (char*)lds + 32768;
    float* wsf = (float*)(lds + 65536) + wid * 64; float* biasR = (float*)(lds + 65536 + 2048);
    const bf16* P = (const bf16*)(p.ws + WS_PROJ); bf16* HA = (bf16*)(p.ws + WS_HA);
    const int sr = tid >> 4, sc = (tid & 15) * 8, vst0 = v_st(sr, sc), vst1 = v_st(32 + sr, sc);
    const int vb0 = (int)(uintptr_t)V_lds + v_rd_base(lane);
    for (int unit = blockIdx.x; unit < AH * (S / 256); unit += gridDim.x) {
        const int h = unit & 7, u = unit >> 3;
        __syncthreads();
        if (tid < 320) { const int e = 319 - tid; biasR[tid] = SQ * p.in[8][h * 257 + (e > 256 ? 256 : e)]; }
        bf16x8 qr[8];
        { const bf16* Qw = P + (size_t)(256 * u + 32 * wid + r32) * NP + C_AQ + h * 128 + hi * 8;
#pragma unroll
          for (int d0 = 0; d0 < 8; ++d0) qr[d0] = *(const bf16x8*)(Qw + d0 * 16); }
        const int qi = wid >> 1, qin = 32 * (wid & 1) + r32;
        const int j0 = (8 - 4 * u) > 0 ? (8 - 4 * u) : 0;
        const bf16* Kg = P + C_AK + h * 128 + sc; const bf16* Vg = P + C_AV + h * 128 + sc;
        bf16x8 vs0, vs1, ks0, ks1;
#define ASLOAD(j) do { const size_t r0_ = (size_t)((4 * u - 8 + (j)) * 64 + sr) * NP; vs0 = *(const bf16x8*)(Vg + r0_); vs1 = *(const bf16x8*)(Vg + r0_ + (size_t)32 * NP); \
        ks0 = *(const bf16x8*)(Kg + r0_); ks1 = *(const bf16x8*)(Kg + r0_ + (size_t)32 * NP); } while (0)
#define ASWRITE(b) do { *(bf16x8*)(V_lds + (b) * 16384 + vst0) = vs0; *(bf16x8*)(V_lds + (b) * 16384 + vst1) = vs1; const int kc_ = sc * 2; \
        *(bf16x8*)(K_lds + (b) * 16384 + KSWZ(sr, kc_)) = ks0; *(bf16x8*)(K_lds + (b) * 16384 + KSWZ(32 + sr, kc_)) = ks1; } while (0)
        ASLOAD(j0); ASWRITE(0);
        __syncthreads();
        float m_reg = -1e30f, l_reg = 0.f; f32x16 o[4];
#pragma unroll
        for (int d = 0; d < 4; ++d)
#pragma unroll
            for (int r = 0; r < 16; ++r) o[d][r] = 0.f;
        for (int j = j0; j < 12; ++j) {
            const int cur = (j - j0) & 1;
            if (j + 1 < 12) ASLOAD(j + 1);
            if (j >= qi && j <= qi + 8) {
                const int dlt = qi + 8 - j;
                f32x16 p0, p1;
                if (dlt >= 3) { const float cf = biasR[0];
#pragma unroll
                    for (int r = 0; r < 16; ++r) { p0[r] = cf; p1[r] = cf; } }
                else { const float* bp = biasR + (191 - qin - 64 * dlt + 4 * hi);
#pragma unroll
                    for (int r = 0; r < 16; ++r) { p0[r] = bp[(r & 3) + 8 * (r >> 2)]; p1[r] = bp[32 + (r & 3) + 8 * (r >> 2)]; } }
                qkt(p0, p1, K_lds + cur * 16384, qr, r32, hi);
                float pmax = p0[0];
#pragma unroll
                for (int r = 1; r < 16; ++r) pmax = fmaxf(pmax, p0[r]);
#pragma unroll
                for (int r = 0; r < 16; ++r) pmax = fmaxf(pmax, p1[r]);
                pmax = swap_max(pmax);
                const float mn = fmaxf(m_reg, pmax), alpha = __builtin_amdgcn_exp2f((m_reg - mn) * CL2); m_reg = mn;
                const float mnC = -mn * CL2; float ps = 0.f;
#pragma unroll
                for (int r = 0; r < 16; ++r) { p0[r] = __builtin_amdgcn_exp2f(fmaf(p0[r], CL2, mnC)); p1[r] = __builtin_amdgcn_exp2f(fmaf(p1[r], CL2, mnC)); ps += p0[r] + p1[r]; }
                ps = swap_add(ps); l_reg = l_reg * alpha + ps;
                if (__any(alpha < 1.f)) { if (hi == 0) wsf[r32] = alpha; asm volatile("s_waitcnt lgkmcnt(0)" ::: "memory");
#pragma unroll
                    for (int d = 0; d < 4; ++d)
#pragma unroll
                        for (int r = 0; r < 16; ++r) o[d][r] *= wsf[crow(r, hi)]; }
                bf16x8 pa0, pa1, pa2, pa3; pack_p(p0, p1, pa0, pa1, pa2, pa3);
                const int vb = vb0 + cur * 16384;
                pv_one<0>(o[0], vb, pa0, pa1, pa2, pa3); pv_one<1>(o[1], vb, pa0, pa1, pa2, pa3); pv_one<2>(o[2], vb, pa0, pa1, pa2, pa3); pv_one<3>(o[3], vb, pa0, pa1, pa2, pa3);
            }
            if (j + 1 < 12) ASWRITE(cur ^ 1);
            __syncthreads();
        }
#undef ASLOAD
#undef ASWRITE
        if (hi == 0) wsf[32 + r32] = l_reg; asm volatile("s_waitcnt lgkmcnt(0)" ::: "memory");
        bf16* Ow = HA + (size_t)(256 * u + 32 * wid) * 1024 + h * 128 + r32;
#pragma unroll
        for (int r = 0; r < 16; ++r) { const int orow = crow(r, hi); const float rl = __builtin_amdgcn_rcpf(wsf[32 + orow]);
#pragma unroll
            for (int d0 = 0; d0 < 4; ++d0) Ow[(size_t)orow * 1024 + d0 * 32] = (bf16)f2bf(o[d0][r] * rl); }
    }
}
}
using att::v_rd_base;

__device__ __forceinline__ void phase_mlstm_local(const Ptrs& p, unsigned char* lds, int wid_) {
    const int wid = wid_, lane = lane_id(), tid = wid * 64 + lane, r32 = lane & 31, hi = lane >> 5;
    char* WK_lds = (char*)lds; char* V_lds = (char*)lds + 16384; float* gsh = (float*)(lds + 49152);
    const bf16* P = (const bf16*)(p.ws + WS_PROJ); bf16* QC = (bf16*)(p.ws + WS_QC); bf16* KC = (bf16*)(p.ws + WS_KC);
    const float* cw = p.in[3]; const float* cb = p.in[4];
    const float* LI = (const float*)(p.ws + WS_LI); const float* LF = (const float*)(p.ws + WS_LF);
    const int vbK = (int)(uintptr_t)WK_lds + v_rd_base(lane), vbV = (int)(uintptr_t)V_lds + v_rd_base(lane);
    for (int unit = blockIdx.x; unit < NCH * MH; unit += gridDim.x) {
        const int c = unit & 127, h = unit >> 7, t0 = c * 64;
        __syncthreads();
        { float b = LF[h * S + t0 + lane];
#pragma unroll
          for (int o = 1; o < 64; o <<= 1) { const float v = __shfl_up(b, o); if (lane >= o) b += v; }
          const float btot = __shfl(b, 63), wl = btot - b + LI[h * S + t0 + lane], m = wave_max(wl), wgt = __expf(wl - m);
          if (wid == 0) { gsh[lane] = wgt; if (lane == 0) { ((float*)(p.ws + WS_MLOC))[h * 128 + c] = m; ((float*)(p.ws + WS_BTOT))[h * 128 + c] = btot; } } }
        __syncthreads();
        { const int t = tid >> 3, cg = tid & 7; const float wgt = gsh[t];
#pragma unroll
          for (int which = 0; which < 2; ++which)
#pragma unroll
              for (int blk = 0; blk < 2; ++blk) { const int ch = cg * 16 + blk * 8, gch = which * 512 + h * 128 + ch;
                  float y[8];
                  { const f32x4 b0 = *(const f32x4*)(cb + gch), b1 = *(const f32x4*)(cb + gch + 4); y[0] = b0[0]; y[1] = b0[1]; y[2] = b0[2]; y[3] = b0[3]; y[4] = b1[0]; y[5] = b1[1]; y[6] = b1[2]; y[7] = b1[3]; }
#pragma unroll
                  for (int tap = 0; tap < 4; ++tap) { const int tt = t0 + t - 3 + tap;
                      if (tt >= 0) { const bf16x8 xv = *(const bf16x8*)(P + (size_t)tt * NP + gch); const f32x4 w0 = *(const f32x4*)(cw + tap * 1024 + gch), w1 = *(const f32x4*)(cw + tap * 1024 + gch + 4);
#pragma unroll
                          for (int e = 0; e < 8; ++e) y[e] += (e < 4 ? w0[e & 3] : w1[e & 3]) * bf2f((unsigned short)xv[e]); } }
#pragma unroll
                  for (int e = 0; e < 8; ++e) y[e] = y[e] * sigmoidf_(y[e]);
                  if (which == 0) { *(u32x4*)(QC + (size_t)(t0 + t) * 512 + h * 128 + ch) = (u32x4){pk2(y[0], y[1]), pk2(y[2], y[3]), pk2(y[4], y[5]), pk2(y[6], y[7])}; }
                  else {
#pragma unroll
                      for (int e = 0; e < 8; ++e) y[e] *= att::SCALE;
                      const u32x4 kb = (u32x4){pk2(y[0], y[1]), pk2(y[2], y[3]), pk2(y[4], y[5]), pk2(y[6], y[7])};
                      *(u32x4*)(KC + (size_t)(t0 + t) * 512 + h * 128 + ch) = kb;
                      u32x4 wk;
#pragma unroll
                      for (int e = 0; e < 4; ++e) { const float lo = __builtin_bit_cast(float, kb[e] << 16) * wgt, hi2 = __builtin_bit_cast(float, kb[e] & 0xffff0000u) * wgt; wk[e] = pk2(lo, hi2); }
                      *(u32x4*)(WK_lds + att::v_st(t, ch)) = wk; } }
#pragma unroll
          for (int i = 0; i < 4; ++i) { const int idx = tid + NTHR * i, tv = idx >> 5, c8 = (idx & 31) * 8;
              *(bf16x8*)(V_lds + (c8 >> 7) * 16384 + att::v_st(tv, c8 & 127)) = *(const bf16x8*)(P + (size_t)(t0 + tv) * NP + C_MV + h * 256 + c8); } }
        __syncthreads();
        { bf16x8 a0, a1, a2, a3; att::frag4<0>(vbV + (wid >> 2) * 16384 + (wid & 3) * 512, a0, a1, a2, a3);
          float* CLw = p.out + ((size_t)(h * 128 + c) * 256 + 32 * wid) * 128 + r32;
#pragma unroll
          for (int dkb = 0; dkb < 4; ++dkb) { bf16x8 b0, b1, b2, b3; att::frag4<0>(vbK + dkb * 512, b0, b1, b2, b3);
              att::f32x16 acc;
#pragma unroll
              for (int r = 0; r < 16; ++r) acc[r] = 0.f;
              acc = __builtin_amdgcn_mfma_f32_32x32x16_bf16(a0, b0, acc, 0, 0, 0); acc = __builtin_amdgcn_mfma_f32_32x32x16_bf16(a1, b1, acc, 0, 0, 0);
              acc = __builtin_amdgcn_mfma_f32_32x32x16_bf16(a2, b2, acc, 0, 0, 0); acc = __builtin_amdgcn_mfma_f32_32x32x16_bf16(a3, b3, acc, 0, 0, 0);
#pragma unroll
              for (int r = 0; r < 16; ++r) CLw[(size_t)att::crow(r, hi) * 128 + dkb * 32] = acc[r]; } }
        if (tid < 128) { float sum = 0.f;
#pragma unroll 8
            for (int t = 0; t < 64; ++t) sum += bf2f(*(const unsigned short*)(WK_lds + att::v_st(t, tid)));
            ((float*)(p.ws + WS_NLOC))[(h * 128 + c) * 128 + tid] = sum; }
    }
}

__device__ __forceinline__ void phase_mlstm_out(const Ptrs& p, unsigned char* lds, int wid_) {
    const int wid = wid_, lane = lane_id(), tid = wid * 64 + lane, r32 = lane & 31, hi = lane >> 5, thalf = wid >> 2, dvq = wid & 3;
    char* K_lds = (char*)lds; char* V_lds = (char*)lds + 16384;
    float* bsh = (float*)(lds + 49152); float* lish = bsh + 64; float* nsh = lish + 64; float* rss = nsh + 128; float* wsf = rss + 256 + wid * 64;
    const bf16* P = (const bf16*)(p.ws + WS_PROJ); const bf16* QC = (const bf16*)(p.ws + WS_QC); const bf16* KC = (const bf16*)(p.ws + WS_KC);
    const float* LI = (const float*)(p.ws + WS_LI); const float* LF = (const float*)(p.ws + WS_LF);
    bf16* HM = (bf16*)(p.ws + WS_HM);
    const int vb = (int)(uintptr_t)V_lds + (dvq >> 1) * 16384 + (2 * (dvq & 1)) * 512 + att::v_rd_base(lane);
    for (int unit = blockIdx.x; unit < NCH * MH; unit += gridDim.x) {
        const int c = unit & 127, h = unit >> 7, t0 = c * 64;
        __syncthreads();
        { const int sr = tid >> 4, sc = (tid & 15) * 8;
          *(bf16x8*)(K_lds + KSWZ(sr, sc * 2)) = *(const bf16x8*)(KC + (size_t)(t0 + sr) * 512 + h * 128 + sc);
          *(bf16x8*)(K_lds + KSWZ(32 + sr, sc * 2)) = *(const bf16x8*)(KC + (size_t)(t0 + 32 + sr) * 512 + h * 128 + sc);
#pragma unroll
          for (int i = 0; i < 4; ++i) { const int idx = tid + NTHR * i, tv = idx >> 5, c8 = (idx & 31) * 8;
              *(bf16x8*)(V_lds + (c8 >> 7) * 16384 + att::v_st(tv, c8 & 127)) = *(const bf16x8*)(P + (size_t)(t0 + tv) * NP + C_MV + h * 256 + c8); } }
        if (wid == 0) { float b = LF[h * S + t0 + lane];
#pragma unroll
            for (int o = 1; o < 64; o <<= 1) { const float v = __shfl_up(b, o); if (lane >= o) b += v; }
            bsh[lane] = b; lish[lane] = LI[h * S + t0 + lane]; }
        if (wid == 1) { const float* np = (const float*)(p.ws + WS_NPREV) + (h * 128 + c) * 128; nsh[lane] = np[lane]; nsh[64 + lane] = np[64 + lane]; }
        bf16x8 qr[8];
        { const bf16* Qw = QC + (size_t)(t0 + 32 * thalf + r32) * 512 + h * 128 + hi * 8;
#pragma unroll
          for (int d0 = 0; d0 < 8; ++d0) qr[d0] = *(const bf16x8*)(Qw + d0 * 16); }
        __syncthreads();
        const float mprev = ((const float*)(p.ws + WS_MPREV))[h * 128 + c];
        att::f32x16 p0, p1;
#pragma unroll
        for (int r = 0; r < 16; ++r) { p0[r] = 0.f; p1[r] = 0.f; }
        att::qkt(p0, p1, K_lds, qr, r32, hi);
        const int t = 32 * thalf + r32; const float bt = bsh[t];
        float mt = bt + mprev;
#pragma unroll
        for (int r = 0; r < 16; ++r) { const int s0 = att::crow(r, hi), s1 = 32 + s0;
            if (s0 <= t) mt = fmaxf(mt, bt - bsh[s0] + lish[s0]);
            if (s1 <= t) mt = fmaxf(mt, bt - bsh[s1] + lish[s1]); }
        mt = att::swap_max(mt);
        float psum = 0.f;
#pragma unroll
        for (int r = 0; r < 16; ++r) { const int s0 = att::crow(r, hi), s1 = 32 + s0;
            p0[r] = (s0 <= t) ? __expf(bt - bsh[s0] + lish[s0] - mt) * p0[r] : 0.f;
            p1[r] = (s1 <= t) ? __expf(bt - bsh[s1] + lish[s1] - mt) * p1[r] : 0.f; psum += p0[r] + p1[r]; }
        psum = att::swap_add(psum);
        float qn = 0.f;
#pragma unroll
        for (int d0 = 0; d0 < 8; ++d0) { const f32x4 n0 = *(const f32x4*)(nsh + 16 * d0 + 8 * hi), n1 = *(const f32x4*)(nsh + 16 * d0 + 8 * hi + 4);
#pragma unroll
            for (int e = 0; e < 8; ++e) qn += bf2f((unsigned short)qr[d0][e]) * (e < 4 ? n0[e & 3] : n1[e & 3]); }
        qn = att::swap_add(qn);
        { const float ai = __expf(bt + mprev - mt), den = psum + ai * qn, inv = 1.f / fmaxf(fabsf(den), __expf(-mt));
          if (hi == 0) { wsf[r32] = ai; wsf[32 + r32] = inv; } }
        bf16x8 pa0, pa1, pa2, pa3; att::pack_p(p0, p1, pa0, pa1, pa2, pa3);
        att::f32x16 oi[2], oc[2];
#pragma unroll
        for (int b = 0; b < 2; ++b)
#pragma unroll
            for (int r = 0; r < 16; ++r) { oi[b][r] = 0.f; oc[b][r] = 0.f; }
        att::pv_one<0>(oi[0], vb, pa0, pa1, pa2, pa3); att::pv_one<0>(oi[1], vb + 512, pa0, pa1, pa2, pa3);
#pragma unroll
        for (int b = 0; b < 2; ++b) { const float* cp = p.out + ((size_t)(h * 128 + c) * 256 + 64 * dvq + 32 * b + r32) * 128 + 8 * hi;
#pragma unroll
            for (int ks = 0; ks < 8; ++ks) { const f32x4 c0 = *(const f32x4*)(cp + 16 * ks), c1 = *(const f32x4*)(cp + 16 * ks + 4);
                const u32x4 w = (u32x4){att::cvtpk(c0[0], c0[1]), att::cvtpk(c0[2], c0[3]), att::cvtpk(c1[0], c1[1]), att::cvtpk(c1[2], c1[3])};
                oc[b] = __builtin_amdgcn_mfma_f32_32x32x16_bf16(qr[ks], __builtin_bit_cast(bf16x8, w), oc[b], 0, 0, 0); } }
        asm volatile("s_waitcnt lgkmcnt(0)" ::: "memory");
        float ssr[16];
#pragma unroll
        for (int r = 0; r < 16; ++r) { const int row = att::crow(r, hi); const float a = wsf[row], iv = wsf[32 + row];
            oi[0][r] = (oi[0][r] + a * oc[0][r]) * iv; oi[1][r] = (oi[1][r] + a * oc[1][r]) * iv;
            float ss = oi[0][r] * oi[0][r] + oi[1][r] * oi[1][r];
            ss += __shfl_xor(ss, 1); ss += __shfl_xor(ss, 2); ss += __shfl_xor(ss, 4); ss += __shfl_xor(ss, 8); ss += __shfl_xor(ss, 16);
            ssr[r] = ss; }
        if (r32 == 0) {
#pragma unroll
            for (int r = 0; r < 16; ++r) rss[(thalf * 4 + dvq) * 32 + att::crow(r, hi)] = ssr[r]; }
        __syncthreads();
        { const float mn0 = p.in[7][h * 256 + 64 * dvq + r32], mn1 = p.in[7][h * 256 + 64 * dvq + 32 + r32];
#pragma unroll
          for (int r = 0; r < 16; ++r) { const int row = att::crow(r, hi);
              const float ss = (rss[(thalf * 4 + 0) * 32 + row] + rss[(thalf * 4 + 1) * 32 + row]) + (rss[(thalf * 4 + 2) * 32 + row] + rss[(thalf * 4 + 3) * 32 + row]);
              const float rn = rsqrtf(ss * (1.f / 256.f) + EPS); const size_t tr = (size_t)(t0 + 32 * thalf + row);
              const float o0 = bf2f(P[tr * NP + C_MO + h * 256 + 64 * dvq + r32]), o1 = bf2f(P[tr * NP + C_MO + h * 256 + 64 * dvq + 32 + r32]);
              HM[tr * 1024 + h * 256 + 64 * dvq + r32] = (bf16)f2bf(oi[0][r] * rn * mn0 * sigmoidf_(o0));
              HM[tr * 1024 + h * 256 + 64 * dvq + 32 + r32] = (bf16)f2bf(oi[1][r] * rn * mn1 * sigmoidf_(o1)); } }
    }
}

__global__ void __launch_bounds__(NTHR, 2) mega(Ptrs p) {
    extern __shared__ __attribute__((aligned(16))) unsigned char lds[];
    cg::grid_group grid = cg::this_grid();
    const int WID = __builtin_amdgcn_readfirstlane((int)threadIdx.x >> 6);
    unsigned char* ws = p.ws;
    bf16* WIN = (bf16*)(ws + WS_WIN); bf16* XN = (bf16*)(ws + WS_XN); bf16* PROJ = (bf16*)(ws + WS_PROJ);
    bf16* WM = (bf16*)(ws + WS_WM); bf16* WA = (bf16*)(ws + WS_WA); bf16* WO = (bf16*)(ws + WS_WO); bf16* WUP = (bf16*)(ws + WS_WUP); bf16* WDN = (bf16*)(ws + WS_WDN);
    bf16* HM = (bf16*)(ws + WS_HM); bf16* HA = (bf16*)(ws + WS_HA); bf16* MRG = (bf16*)(ws + WS_MRG); bf16* A2 = (bf16*)(ws + WS_A2); bf16* U = (bf16*)(ws + WS_U); bf16* ACT = (bf16*)(ws + WS_ACT);
    phase_transpose(p, lds, WID);
    __syncthreads();
    phase_norm_gates(p, lds, WID);
    grid.sync();
    { pg8::Gemm g{XN, WIN, nullptr, nullptr, D}; pg8::StaticOrder So; So.init(S, NP, gridDim.x, blockIdx.x); pg8::EpiBf16 E{PROJ, NP};
      pg8::gemm_phase<pg8::EpiBf16, pg8::StaticOrder, true, true>((PG8_LAS unsigned char*)lds, g, So, E, WID); }
    grid.sync();
    att::phase_attn(p, lds, WID);
    __syncthreads();
    phase_mlstm_local(p, lds, WID);
    grid.sync();
    phase_scan(p, WID);
    grid.sync();
    phase_mlstm_out(p, lds, WID);
    grid.sync();
    { pg8::Gemm g{HM, WM, HA, WA, 1024}; pg8::StaticOrder So; So.init(S, D, gridDim.x, blockIdx.x, 2); pg8::EpiMerge E{PROJ, p.in[9], MRG};
      pg8::gemm_phase<pg8::EpiMerge, pg8::StaticOrder, true, true>((PG8_LAS unsigned char*)lds, g, So, E, WID); }
    grid.sync();
    { pg8::Gemm g{MRG, WO, nullptr, nullptr, D}; pg8::StaticOrder So; So.init(S, D, gridDim.x, blockIdx.x); pg8::EpiResid1 E{p.in[0], p.out, A2, p.in[13], (float*)(ws + WS_SLAB)};
      pg8::gemm_phase<pg8::EpiResid1, pg8::StaticOrder, false, true>((PG8_LAS unsigned char*)lds, g, So, E, WID); }
    grid.sync();
    phase_rowstat(p, WID);
    { pg8::Gemm g{A2, WUP, nullptr, nullptr, D}; pg8::StaticOrder So; So.init(S, NUP, gridDim.x, blockIdx.x); pg8::EpiBf16 E{U, NUP};
      pg8::gemm_phase<pg8::EpiBf16, pg8::StaticOrder, true, true>((PG8_LAS unsigned char*)lds, g, So, E, WID); }
    grid.sync();
    phase_ffn_conv(p, WID);
    grid.sync();
    { pg8::Gemm g{ACT, WDN, nullptr, nullptr, DFF}; pg8::StaticOrder So; So.init(S, D, gridDim.x, blockIdx.x); pg8::EpiResid2 E{p.out};
      pg8::gemm_phase<pg8::EpiResid2, pg8::StaticOrder, false, true>((PG8_LAS unsigned char*)lds, g, So, E, WID); }
    grid.sync();
    phase_final_norm(p, WID);
}

extern "C" void kernel_launch(void* const* d_in, const int* in_sizes, int n_in, void* d_out, int out_size, void* d_ws, size_t ws_size, hipStream_t stream) {
    static int grid_blocks = 0;
    if (grid_blocks == 0) {
        if (n_in != 19 || out_size != S * D || ws_size < WS_END) { fprintf(stderr, "kernel_launch: unexpected shapes n_in %d out %d ws %zu\n", n_in, out_size, ws_size); grid_blocks = -1; return; }
        int dev = 0, cus = 0, per_cu = 0;
        (void)hipGetDevice(&dev);
        (void)hipDeviceGetAttribute(&cus, hipDeviceAttributeMultiprocessorCount, dev);
        (void)hipFuncSetAttribute((const void*)mega, hipFuncAttributeMaxDynamicSharedMemorySize, LDS_BYTES);
        (void)hipOccupancyMaxActiveBlocksPerMultiprocessor(&per_cu, (const void*)mega, NTHR, LDS_BYTES);
        if (per_cu < 1) { fprintf(stderr, "kernel_launch: occupancy query returned %d\n", per_cu); per_cu = 1; }
        if (per_cu > 1) per_cu = 1;
        grid_blocks = cus * per_cu;
        fprintf(stderr, "kernel_launch: cus %d per_cu %d grid %d\n", cus, per_cu, grid_blocks);
    }
    if (grid_blocks < 0) return;
    Ptrs p{};
    for (int i = 0; i < 19; ++i) p.in[i] = (const float*)d_in[i];
    p.out = (float*)d_out; p.ws = (unsigned char*)d_ws;
    void* args[] = {&p};
    hipError_t e = hipLaunchCooperativeKernel((const void*)mega, dim3(grid_blocks), dim3(NTHR), args, LDS_BYTES, stream);
    if (e != hipSuccess) fprintf(stderr, "cooperative launch failed: %s (grid %d)\n", hipGetErrorString(e), grid_blocks);
}
```

```cpp
#include <hip/hip_runtime.h>
#include <cstdint>
#include <cstdio>
#include <hip/hip_cooperative_groups.h>
namespace cg = cooperative_groups;

typedef unsigned short bf16;
typedef short bf16x8 __attribute__((ext_vector_type(8)));
typedef float f32x4 __attribute__((ext_vector_type(4)));
typedef unsigned u32x4 __attribute__((ext_vector_type(4)));
typedef unsigned u32x2 __attribute__((ext_vector_type(2)));

constexpr int S = 8192, D = 2048, WIN_N = 10248, NP = 10240, DFF = 5632, NUP = 11264;
constexpr int CH = 64, NCH = 128;
constexpr int MH = 4, MDK = 128, MDV = 256, AH = 8, ADH = 128;
constexpr int C_MQ = 0, C_MK = 512, C_MV = 1024, C_MO = 2048, C_AQ = 3072, C_AK = 4096, C_AV = 5120, C_GM = 6144, C_GA = 8192;
constexpr float EPS = 1e-6f, NEGF = -1e30f;

constexpr size_t MiB = 1u << 20;
constexpr size_t WS_WIN = 0;
constexpr size_t WS_XN = 40 * MiB;
constexpr size_t WS_QC = 0;
constexpr size_t WS_KC = 8 * MiB;
constexpr size_t WS_A2 = 0;
constexpr size_t WS_MRG = 32 * MiB;
constexpr size_t WS_ACT = 0;
constexpr size_t WS_WM = 72 * MiB, WS_WA = 76 * MiB, WS_WO = 80 * MiB, WS_WUP = 88 * MiB, WS_WDN = 132 * MiB;
constexpr size_t WS_PROJ = 154 * MiB;
constexpr size_t WS_HM = 314 * MiB, WS_HA = 330 * MiB;
constexpr size_t WS_U = 154 * MiB;
constexpr size_t WS_MISC = 346 * MiB;
constexpr size_t WS_LI = WS_MISC, WS_LF = WS_LI + 131072, WS_MLOC = WS_LF + 131072, WS_BTOT = WS_MLOC + 2048, WS_MPREV = WS_BTOT + 2048,
                 WS_NLOC = WS_MPREV + 2048, WS_NPREV = WS_NLOC + 262144, WS_RS2 = WS_NPREV + 262144, WS_SLAB = WS_RS2 + 32768, WS_CTL = WS_SLAB + 32 * 8192 * 4, WS_END = WS_CTL + 16384;
static_assert(WS_END <= 348 * MiB, "ws map");

__device__ __forceinline__ unsigned f2bf(float f) { unsigned u = __builtin_bit_cast(unsigned, f); return (u + 0x7fffu + ((u >> 16) & 1u)) >> 16; }
__device__ __forceinline__ float bf2f(unsigned short b) { return __builtin_bit_cast(float, (unsigned)b << 16); }
__device__ __forceinline__ unsigned pk2(float lo, float hi) { return f2bf(lo) | (f2bf(hi) << 16); }
__device__ __forceinline__ float wave_sum(float v) {
#pragma unroll
    for (int o = 1; o < 64; o <<= 1) v += __shfl_xor(v, o);
    return v;
}
__device__ __forceinline__ float wave_max(float v) {
#pragma unroll
    for (int o = 1; o < 64; o <<= 1) v = fmaxf(v, __shfl_xor(v, o));
    return v;
}
__device__ __forceinline__ int lane_id() { int r; asm volatile("v_mbcnt_lo_u32_b32 %0, -1, 0\n\tv_mbcnt_hi_u32_b32 %0, -1, %0" : "=v"(r)); return r; }
__device__ __forceinline__ float sigmoidf_(float x) { return 1.f / (1.f + __expf(-x)); }

__device__ __forceinline__ int src_col(int mode, int n0) {
    if (mode == 1) return n0 < 3072 ? n0 : n0 + 8;
    if (mode == 2) { const int j = n0 >> 8, i = n0 & 255; return i < 128 ? 128 * j + i : DFF + 128 * j + (i - 128); }
    return n0;
}
__device__ __forceinline__ void transpose_item(const float* W, int K, int Nsrc, int Ndst, bf16* WT, int mode, float* scr, int item, int lane) {
    const int nblk = Ndst / 32, kb = item / nblk, nb = item % nblk, k0 = 64 * kb, n0 = 32 * nb, s0 = src_col(mode, n0);
#pragma unroll 8
    for (int i = 0; i < 32; ++i) { const int kk = 2 * i + (lane >> 5); scr[kk * 33 + (lane & 31)] = W[(size_t)(k0 + kk) * Nsrc + s0 + (lane & 31)]; }
    __builtin_amdgcn_s_waitcnt(0xc07f); asm volatile("" ::: "memory");
    const int c = lane & 7;
#pragma unroll
    for (int j = 0; j < 4; ++j) { const int n = (lane >> 3) + 8 * j; const float* s = scr + (8 * c) * 33 + n;
        u32x4 o; o.x = pk2(s[0 * 33], s[1 * 33]); o.y = pk2(s[2 * 33], s[3 * 33]); o.z = pk2(s[4 * 33], s[5 * 33]); o.w = pk2(s[6 * 33], s[7 * 33]);
        *(u32x4*)(WT + (size_t)(n0 + n) * K + k0 + 8 * c) = o; }
    __builtin_amdgcn_s_waitcnt(0xc07f); asm volatile("" ::: "memory");
}
struct Ptrs {
    const float* in[19]; float* out; unsigned char* ws;
};
constexpr int IT_WIN = (D / 64) * (NP / 32), IT_WM = (1024 / 64) * (D / 32), IT_WO = (D / 64) * (D / 32), IT_WUP = (D / 64) * (NUP / 32), IT_WDN = (DFF / 64) * (D / 32);
constexpr int IT_TOTAL = IT_WIN + 2 * IT_WM + IT_WO + IT_WUP + IT_WDN;


constexpr int NTHR = 512;
constexpr int LDS_BYTES = 147456;

__device__ __forceinline__ void phase_transpose(const Ptrs& p, unsigned char* lds, int wid_) {
    const int TIDX = wid_ * 64 + lane_id();
    const int lane = TIDX & 63, wave = TIDX >> 6;
    float* scr = (float*)lds + wave * 64 * 33;
    const int gw = blockIdx.x * 8 + wave, NGW = gridDim.x * 8;
    for (int it = gw; it < IT_TOTAL; it += NGW) {
        int r = it;
        if (r < IT_WIN) { transpose_item(p.in[2], D, WIN_N, NP, (bf16*)(p.ws + WS_WIN), 1, scr, r, lane); continue; } r -= IT_WIN;
        if (r < IT_WM) { transpose_item(p.in[10], 1024, D, D, (bf16*)(p.ws + WS_WM), 0, scr, r, lane); continue; } r -= IT_WM;
        if (r < IT_WM) { transpose_item(p.in[11], 1024, D, D, (bf16*)(p.ws + WS_WA), 0, scr, r, lane); continue; } r -= IT_WM;
        if (r < IT_WO) { transpose_item(p.in[12], D, D, D, (bf16*)(p.ws + WS_WO), 0, scr, r, lane); continue; } r -= IT_WO;
        if (r < IT_WUP) { transpose_item(p.in[14], D, NUP, NUP, (bf16*)(p.ws + WS_WUP), 2, scr, r, lane); continue; } r -= IT_WUP;
        transpose_item(p.in[17], DFF, D, D, (bf16*)(p.ws + WS_WDN), 0, scr, r, lane);
    }
}

__device__ __forceinline__ void phase_norm_gates(const Ptrs& p, unsigned char* lds, int wid_) {
    const int TIDX = wid_ * 64 + lane_id();
    float* wgs = (float*)lds;
    const float* w_in = p.in[2];
    for (int i = TIDX; i < 2048 * 8; i += NTHR) wgs[i] = w_in[(size_t)(i >> 3) * WIN_N + 3072 + (i & 7)];
    __syncthreads();
    const int lane = TIDX & 63, wave = TIDX >> 6;
    const int gw = blockIdx.x * 8 + wave, NGW = gridDim.x * 8;
    const float* x = p.in[0]; const f32x4* g4 = (const f32x4*)p.in[1];
    bf16* XN = (bf16*)(p.ws + WS_XN); float* LI = (float*)(p.ws + WS_LI); float* LF = (float*)(p.ws + WS_LF);
    for (int row = gw; row < S; row += NGW) {
        const f32x4* xr = (const f32x4*)(x + (size_t)row * D);
        float ss = 0.f;
#pragma unroll
        for (int j = 0; j < 8; ++j) { const f32x4 v = xr[64 * j + lane]; ss += (v.x * v.x + v.y * v.y) + (v.z * v.z + v.w * v.w); }
        const float r = rsqrtf(wave_sum(ss) * (1.f / D) + EPS);
        float d0 = 0.f, d1 = 0.f, d2 = 0.f, d3 = 0.f, d4 = 0.f, d5 = 0.f, d6 = 0.f, d7 = 0.f;
#pragma unroll 1
        for (int j = 0; j < 8; ++j) {
            const f32x4 g = g4[64 * j + lane]; const f32x4 hv = xr[64 * j + lane] * r * g;
            *(u32x2*)(XN + (size_t)row * D + 4 * (64 * j + lane)) = (u32x2){pk2(hv.x, hv.y), pk2(hv.z, hv.w)};
            const float* w = wgs + (size_t)(4 * (64 * j + lane)) * 8;
#pragma unroll
            for (int e = 0; e < 4; ++e) { const f32x4 w0 = *(const f32x4*)(w + 8 * e), w1 = *(const f32x4*)(w + 8 * e + 4);
                const float hh = e == 0 ? hv.x : e == 1 ? hv.y : e == 2 ? hv.z : hv.w;
                d0 += hh * w0.x; d1 += hh * w0.y; d2 += hh * w0.z; d3 += hh * w0.w;
                d4 += hh * w1.x; d5 += hh * w1.y; d6 += hh * w1.z; d7 += hh * w1.w; }
        }
        float dots[8] = {d0, d1, d2, d3, d4, d5, d6, d7};
#pragma unroll
        for (int q = 0; q < 8; ++q) dots[q] = wave_sum(dots[q]);
        if (lane < 4) { float dv = lane == 0 ? dots[0] : lane == 1 ? dots[1] : lane == 2 ? dots[2] : dots[3]; LI[lane * S + row] = dv + p.in[5][lane]; }
        else if (lane < 8) { const int hh = lane - 4; float dv = hh == 0 ? dots[4] : hh == 1 ? dots[5] : hh == 2 ? dots[6] : dots[7];
            const float z = dv + p.in[6][hh]; const float ee = __expf(-fabsf(z)), uu = 1.f + ee; const float l1p = (uu == 1.f) ? ee : __logf(uu) * (ee / (uu - 1.f)); LF[hh * S + row] = fminf(z, 0.f) - l1p; }
    }
}

__device__ __forceinline__ void phase_scan(const Ptrs& p, int wid_) {
    const int TIDX = wid_ * 64 + lane_id();
    float* CL = p.out; const float* MLOC = (const float*)(p.ws + WS_MLOC); const float* BTOT = (const float*)(p.ws + WS_BTOT);
    float* MPREV = (float*)(p.ws + WS_MPREV); const float* NLOC = (const float*)(p.ws + WS_NLOC); float* NPREV = (float*)(p.ws + WS_NPREV);
    const int tid = TIDX;
    for (int vb = blockIdx.x; vb < 256; vb += gridDim.x) {
        const int h = vb >> 6, rest = ((vb & 63) << 9) + tid;
        const bool nthr = ((vb & 63) == 0) && tid < 128, mthr = ((vb & 63) == 0) && tid == 0;
        float m = NEGF, st = 0.f, nst = 0.f;
#pragma unroll 1
        for (int c0 = 0; c0 < NCH; c0 += 8) {
            float val[8], nv[8];
#pragma unroll
            for (int i = 0; i < 8; ++i) { val[i] = CL[((size_t)(h * 128 + c0 + i) << 15) + rest]; nv[i] = nthr ? NLOC[(h * 128 + c0 + i) * 128 + tid] : 0.f; }
#pragma unroll
            for (int i = 0; i < 8; ++i) { const int c = c0 + i;
                const float bt = BTOT[h * 128 + c], ml = MLOC[h * 128 + c];
                CL[((size_t)(h * 128 + c) << 15) + rest] = st;
                if (nthr) NPREV[(h * 128 + c) * 128 + tid] = nst;
                if (mthr) MPREV[h * 128 + c] = m;
                const float mn = fmaxf(bt + m, ml), a = __expf(bt + m - mn), cl = __expf(ml - mn);
                st = a * st + cl * val[i]; nst = a * nst + cl * nv[i]; m = mn; }
        }
    }
}

__device__ __forceinline__ void phase_rowstat(const Ptrs& p, int wid_) {
    const int TIDX = wid_ * 64 + lane_id();
    float* RS2 = (float*)(p.ws + WS_RS2); const float* slab = (const float*)(p.ws + WS_SLAB);
    for (int row = blockIdx.x * NTHR + TIDX; row < S; row += gridDim.x * NTHR) { float ss = 0.f;
#pragma unroll
        for (int i = 0; i < 32; ++i) ss += slab[(size_t)i * S + row];
        RS2[row] = rsqrtf(ss * (1.f / D) + EPS); }
}

__device__ __forceinline__ void phase_ffn_conv(const Ptrs& p, int wid_) {
    const int TIDX = wid_ * 64 + lane_id();
    const int lane = TIDX & 63, gw = blockIdx.x * 8 + (TIDX >> 6), NGW = gridDim.x * 8;
    const bf16* U = (const bf16*)(p.ws + WS_U); bf16* ACT = (bf16*)(p.ws + WS_ACT); const float* RS2 = (const float*)(p.ws + WS_RS2);
    const float* cw = p.in[15]; const float* cb = p.in[16];
    constexpr int NCB = DFF / 512, NRB = S / 16;
    for (int unit = gw; unit < NCB * NRB; unit += NGW) {
        const int cbk = unit % NCB, rb = unit / NCB, ch0 = cbk * 512 + lane * 8, j = ch0 >> 7, i0 = ch0 & 127, gcol = 256 * j + i0, vcol = gcol + 128, r0 = rb * 16;
        float w0[8], w1[8], w2[8], bb[8], gm2[8], gm1[8];
#pragma unroll
        for (int e = 0; e < 8; ++e) { w0[e] = cw[ch0 + e]; w1[e] = cw[DFF + ch0 + e]; w2[e] = cw[2 * DFF + ch0 + e]; bb[e] = cb[ch0 + e]; gm2[e] = 0.f; gm1[e] = 0.f; }
        if (r0 >= 2) { const float ra = RS2[r0 - 2], rbv = RS2[r0 - 1];
            const bf16x8 a = *(const bf16x8*)(U + (size_t)(r0 - 2) * NUP + gcol), b = *(const bf16x8*)(U + (size_t)(r0 - 1) * NUP + gcol);
#pragma unroll
            for (int e = 0; e < 8; ++e) { gm2[e] = ra * bf2f((unsigned short)a[e]); gm1[e] = rbv * bf2f((unsigned short)b[e]); } }
#pragma unroll 1
        for (int t = r0; t < r0 + 16; ++t) { const float r = RS2[t];
            const bf16x8 g = *(const bf16x8*)(U + (size_t)t * NUP + gcol), v = *(const bf16x8*)(U + (size_t)t * NUP + vcol); float o[8];
#pragma unroll
            for (int e = 0; e < 8; ++e) { const float g0 = r * bf2f((unsigned short)g[e]); const float cv = bb[e] + w0[e] * gm2[e] + w1[e] * gm1[e] + w2[e] * g0;
                o[e] = cv * sigmoidf_(cv) * (r * bf2f((unsigned short)v[e])); gm2[e] = gm1[e]; gm1[e] = g0; }
            *(u32x4*)(ACT + (size_t)t * DFF + ch0) = (u32x4){pk2(o[0], o[1]), pk2(o[2], o[3]), pk2(o[4], o[5]), pk2(o[6], o[7])}; }
    }
}

__device__ __forceinline__ void phase_final_norm(const Ptrs& p, int wid_) {
    const int TIDX = wid_ * 64 + lane_id();
    const int lane = TIDX & 63, gw = blockIdx.x * 8 + (TIDX >> 6), NGW = gridDim.x * 8;
    const f32x4* g4 = (const f32x4*)p.in[18];
    for (int row = gw; row < S; row += NGW) { f32x4* xr = (f32x4*)(p.out + (size_t)row * D); f32x4 v[8]; float ss = 0.f;
#pragma unroll
        for (int j = 0; j < 8; ++j) { v[j] = xr[64 * j + lane]; ss += (v[j].x * v[j].x + v[j].y * v[j].y) + (v[j].z * v[j].z + v[j].w * v[j].w); }
        const float r = rsqrtf(wave_sum(ss) * (1.f / D) + EPS);
#pragma unroll
        for (int j = 0; j < 8; ++j) xr[64 * j + lane] = v[j] * r * g4[64 * j + lane]; }
}


namespace pg8 {
#define PG8_LAS __attribute__((address_space(3)))
typedef unsigned short bf16_t;
constexpr int BM = 256, BK = 64, HALF = 128, HTB = HALF * BK * 2  , STAGE_BYTES = 8 * HTB, NXCD = 8, WGM = 8;
__host__ __device__ __forceinline__ int lds_byte(int r, int c) { const int st = (r >> 4) * 2 + (c >> 5), rr = r & 15, cc = c & 31, ob = rr * 64 + cc * 2; return st * 1024 + (ob ^ (((ob >> 9) & 1) << 5)); }
__host__ __device__ __forceinline__ void stage_rc(int b, int& R, int& C) { const int st = b / 1024, sb = b % 1024, swz = sb ^ (((sb >> 9) & 1) << 5); R = (st >> 1) * 16 + swz / 64; C = (st & 1) * 32 + (swz % 64) / 2; }
__host__ __device__ __forceinline__ int perm32(int rho) { const int n = rho >> 4, i = rho & 15; return 8 * (i >> 2) + 4 * n + (i & 3); }

struct Unit { int pm, pn, seg; };
struct Gemm { const bf16_t* A; const bf16_t* Bt; const bf16_t* A1; const bf16_t* Bt1; int K;
    __device__ __forceinline__ const char* aptr(const Unit& u) const { return (const char*)(u.seg ? A1 : A) + (size_t)u.pm * BM * K * 2; }
    __device__ __forceinline__ const char* bptr(const Unit& u) const { return (const char*)(u.seg ? Bt1 : Bt) + (size_t)u.pn * BM * K * 2; } };

struct StaticOrder {
    int nM, nN, nwg, G, c, nseg;
    __host__ __device__ void init(int M, int N, int G_, int c_, int nseg_ = 1) { nM = M / BM; nN = N / BM; nwg = nM * nN; G = G_; c = c_; nseg = nseg_; }
    __host__ __device__ bool next(int i, Unit& u) const {
        const int it = i / nseg; u.seg = i - it * nseg;
        const long L = (long)it * G + c; if (L >= nwg) return false;
        int wgid = (int)L; { const int q = nwg / NXCD, r = nwg % NXCD, xcd = wgid % NXCD, off = wgid / NXCD; wgid = (xcd < r ? xcd * (q + 1) : r * (q + 1) + (xcd - r) * q) + off; }
        const int nig = WGM * nN, gid = wgid / nig, fm = gid * WGM, gsz = (nM - fm) < WGM ? (nM - fm) : WGM;
        u.pm = fm + ((wgid % nig) % gsz); u.pn = (wgid % nig) / gsz; return true;
    }
    __device__ __forceinline__ void a_ready(const Unit&) const {}
    __device__ __forceinline__ void done(const Unit&) const {}
};
__device__ __forceinline__ unsigned cvt_pk_bf16(float lo, float hi) { unsigned r; asm volatile("v_cvt_pk_bf16_f32 %0, %1, %2" : "=v"(r) : "v"(lo), "v"(hi)); return r; }

struct EpiBf16 {
    static constexpr bool PERM = true, AFTER_DRAIN = false;
    bf16_t* O; int ldc;
    __device__ __forceinline__ void operator()(f32x4 (&acc)[2][2][4][2], const Unit& u, int wr, int wc, int fr, int fq) const {
        const int row0 = u.pm * BM + wr * 64 + fr, col0 = u.pn * BM + wc * 32 + 8 * fq;
#pragma unroll
        for (int ai = 0; ai < 2; ++ai)
#pragma unroll
            for (int m = 0; m < 4; ++m) { bf16_t* rowp = O + (size_t)(row0 + ai * HALF + m * 16) * ldc + col0;
#pragma unroll
                for (int bj = 0; bj < 2; ++bj) { const f32x4 v0 = acc[ai][bj][m][0], v1 = acc[ai][bj][m][1];
                    u32x4 w; w.x = cvt_pk_bf16(v0[0], v0[1]); w.y = cvt_pk_bf16(v0[2], v0[3]); w.z = cvt_pk_bf16(v1[0], v1[1]); w.w = cvt_pk_bf16(v1[2], v1[3]);
                    *(u32x4*)(rowp + bj * HALF) = w; } }
    }
};

struct EpiResid1 {
    static constexpr bool PERM = true, AFTER_DRAIN = false;
    const float* x; float* out; bf16_t* A2; const float* g; float* slab;
    __device__ __forceinline__ void operator()(f32x4 (&acc)[2][2][4][2], const Unit& u, int wr, int wc, int fr, int fq) const {
        const int row0 = u.pm * BM + wr * 64 + fr, col0 = u.pn * BM + wc * 32 + 8 * fq;
        f32x4 gv[2][2];
#pragma unroll
        for (int bj = 0; bj < 2; ++bj)
#pragma unroll
            for (int n = 0; n < 2; ++n) gv[bj][n] = *(const f32x4*)(g + col0 + bj * HALF + 4 * n);
#pragma unroll
        for (int ai = 0; ai < 2; ++ai)
#pragma unroll
            for (int m = 0; m < 4; ++m) { const int row = row0 + ai * HALF + m * 16; const size_t off = (size_t)row * D + col0; float ss = 0.f;
#pragma unroll
                for (int bj = 0; bj < 2; ++bj) {
                    const f32x4 a0 = *(const f32x4*)(x + off + bj * HALF) + acc[ai][bj][m][0], a1 = *(const f32x4*)(x + off + bj * HALF + 4) + acc[ai][bj][m][1];
                    *(f32x4*)(out + off + bj * HALF) = a0; *(f32x4*)(out + off + bj * HALF + 4) = a1;
                    ss += (a0[0] * a0[0] + a0[1] * a0[1]) + (a0[2] * a0[2] + a0[3] * a0[3]) + (a1[0] * a1[0] + a1[1] * a1[1]) + (a1[2] * a1[2] + a1[3] * a1[3]);
                    const f32x4 b0 = a0 * gv[bj][0], b1 = a1 * gv[bj][1];
                    u32x4 w; w.x = cvt_pk_bf16(b0[0], b0[1]); w.y = cvt_pk_bf16(b0[2], b0[3]); w.z = cvt_pk_bf16(b1[0], b1[1]); w.w = cvt_pk_bf16(b1[2], b1[3]);
                    *(u32x4*)(A2 + off + bj * HALF) = w; }
                ss += __shfl_xor(ss, 16); ss += __shfl_xor(ss, 32);
                if (fq == 0) slab[(size_t)(u.pn * 4 + wc) * S + row] = ss; }
    }
};
struct EpiResid2 {
    static constexpr bool PERM = false, AFTER_DRAIN = false;
    float* out;
    __device__ __forceinline__ void operator()(f32x4 (&acc)[2][2][4][2], const Unit& u, int wr, int wc, int fr, int fq) const {
        const int row0 = u.pm * BM + wr * 64 + fr, col0 = u.pn * BM + wc * 32 + 4 * fq;
#pragma unroll
        for (int ai = 0; ai < 2; ++ai)
#pragma unroll
            for (int m = 0; m < 4; ++m) { const size_t off = (size_t)(row0 + ai * HALF + m * 16) * D + col0;
#pragma unroll
                for (int bj = 0; bj < 2; ++bj)
#pragma unroll
                    for (int n = 0; n < 2; ++n) { float* q = out + off + bj * HALF + n * 16; *(f32x4*)q = *(const f32x4*)q + acc[ai][bj][m][n]; } }
    }
};
struct EpiMerge {
    static constexpr bool PERM = true, AFTER_DRAIN = false;
    const bf16_t* P; const float* gb; bf16_t* O;
    __device__ __forceinline__ void operator()(f32x4 (&acc)[2][2][4][2], const Unit& u, int wr, int wc, int fr, int fq) const {
        const int row0 = u.pm * BM + wr * 64 + fr, col0 = u.pn * BM + wc * 32 + 8 * fq;
        f32x4 bm[2][2], ba[2][2];
#pragma unroll
        for (int bj = 0; bj < 2; ++bj)
#pragma unroll
            for (int n = 0; n < 2; ++n) { bm[bj][n] = *(const f32x4*)(gb + col0 + bj * HALF + 4 * n); ba[bj][n] = *(const f32x4*)(gb + D + col0 + bj * HALF + 4 * n); }
        const bool mid = (u.seg == 0);
#pragma unroll
        for (int ai = 0; ai < 2; ++ai)
#pragma unroll
            for (int m = 0; m < 4; ++m) { const int row = row0 + ai * HALF + m * 16; const bf16_t* prow = P + (size_t)row * NP + col0;
#pragma unroll
                for (int bj = 0; bj < 2; ++bj) {
                    const bf16x8 ga8 = *(const bf16x8*)(prow + C_GA + bj * HALF);
                    float ea[8];
#pragma unroll
                    for (int e = 0; e < 8; ++e) ea[e] = __expf(fminf(-(bf2f((unsigned short)ga8[e]) + ba[bj][e >> 2][e & 3]), 80.f));
                    if (mid) {
                        const bf16x8 gm8 = *(const bf16x8*)(prow + C_GM + bj * HALF);
#pragma unroll
                        for (int e = 0; e < 8; ++e) { const float em = __expf(fminf(-(bf2f((unsigned short)gm8[e]) + bm[bj][e >> 2][e & 3]), 80.f));
                            acc[ai][bj][m][e >> 2][e & 3] *= (1.f + ea[e]) / (1.f + em); }
                    } else {
                        float v[8];
#pragma unroll
                        for (int e = 0; e < 8; ++e) v[e] = acc[ai][bj][m][e >> 2][e & 3] / (1.f + ea[e]);
                        u32x4 w; w.x = cvt_pk_bf16(v[0], v[1]); w.y = cvt_pk_bf16(v[2], v[3]); w.z = cvt_pk_bf16(v[4], v[5]); w.w = cvt_pk_bf16(v[6], v[7]);
                        *(u32x4*)(O + (size_t)row * D + col0 + bj * HALF) = w; } } }
    }
};
template <class Epi, class Sched, bool ALIGN_EPI = false, bool SP2 = false>
__device__ __forceinline__ void gemm_phase(PG8_LAS unsigned char* lds, const Gemm g, const Sched& S, const Epi& E, int wid_) {
    const int wid = wid_, lane = lane_id(), tid = wid * 64 + lane, wr = wid >> 2, wc = wid & 3, fr = lane & 15, fq = lane >> 4;
    const int K = g.K, nt = K / BK;
    unsigned voffA[2], voffB[2];
#pragma unroll
    for (int i = 0; i < 2; ++i) { int R, C; stage_rc(tid * 16 + i * 8192, R, C); const int Rb = Epi::PERM ? ((R & ~31) + perm32(R & 31)) : R;
        voffA[i] = (unsigned)(R * K + C) * 2u; voffB[i] = (unsigned)(Rb * K + C) * 2u; }
    const size_t kstep = (size_t)(BK * 2);
    const size_t hstep = (size_t)HALF * K * 2;
        const unsigned ldsw = (unsigned)wid * 1024u;
    const int aoff = lds_byte(wr * 64 + fr, fq * 8), boff = lds_byte(wc * 32 + fr, fq * 8);
#define PG8_SA(b, h) (((b) * 2 + (h)) * HTB)
#define PG8_SB(b, h) ((4 + (b) * 2 + (h)) * HTB)
#define PG8_STAGE(bufoff, gbase, voff) do { _Pragma("unroll") for (int _i = 0; _i < 2; ++_i) \
        __builtin_amdgcn_global_load_lds((const unsigned*)((const char*)(gbase) + (voff)[_i]), (PG8_LAS unsigned*)(lds + (bufoff) + ldsw + _i * 8192), 16, 0, 0); } while (0)
#define PG8_LDA(dst, b, h) do { _Pragma("unroll") for (int m = 0; m < 4; ++m) _Pragma("unroll") for (int k = 0; k < 2; ++k) dst[m][k] = *(const PG8_LAS bf16x8*)(lds + PG8_SA(b, h) + aoff + m * 2048 + k * 1024); } while (0)
#define PG8_LDB(dst, b, h) do { _Pragma("unroll") for (int n = 0; n < 2; ++n) _Pragma("unroll") for (int k = 0; k < 2; ++k) dst[n][k] = *(const PG8_LAS bf16x8*)(lds + PG8_SB(b, h) + boff + n * 2048 + k * 1024); } while (0)
#define PG8_MMA(ai, bj, At, Bt) do { __builtin_amdgcn_s_setprio(1); _Pragma("unroll") for (int m = 0; m < 4; ++m) _Pragma("unroll") for (int n = 0; n < 2; ++n) _Pragma("unroll") for (int k = 0; k < 2; ++k) \
        acc[ai][bj][m][n] = __builtin_amdgcn_mfma_f32_16x16x32_bf16(Bt[n][k], At[m][k], acc[ai][bj][m][n], 0, 0, 0); __builtin_amdgcn_s_setprio(0); } while (0)
#define PG8_WAIT_V(n) asm volatile("s_waitcnt vmcnt(" #n ")" ::: "memory")
#define PG8_WAIT_L(n) asm volatile("s_waitcnt lgkmcnt(" #n ")" ::: "memory")
#define PG8_BAR __builtin_amdgcn_s_barrier()
#define PG8_SCHED __builtin_amdgcn_sched_barrier(0)
    Unit cur, nxt; int ui = 0;
    if (!S.next(0, cur)) return;
    f32x4 acc[2][2][4][2];
#pragma unroll
    for (int a = 0; a < 2; ++a)
#pragma unroll
        for (int b = 0; b < 2; ++b)
#pragma unroll
            for (int m = 0; m < 4; ++m)
#pragma unroll
                for (int n = 0; n < 2; ++n) acc[a][b][m][n] = (f32x4){0.f, 0.f, 0.f, 0.f};
    bf16x8 At[4][2], B0[2][2], B1[2][2];
    const char* cA = g.aptr(cur); const char* cB = g.bptr(cur);
    S.a_ready(cur);
    if constexpr (SP2) {
        PG8_STAGE(PG8_SB(0, 0), cB, voffB); PG8_STAGE(PG8_SB(0, 1), cB + hstep, voffB); PG8_STAGE(PG8_SA(0, 0), cA, voffA); PG8_STAGE(PG8_SA(0, 1), cA + hstep, voffA);
        if (wr == 1) PG8_BAR;
        PG8_WAIT_V(2); PG8_BAR;
        PG8_STAGE(PG8_SB(1, 0), cB + kstep, voffB); PG8_STAGE(PG8_SA(1, 0), cA + kstep, voffA); PG8_STAGE(PG8_SB(1, 1), cB + hstep + kstep, voffB);
        PG8_WAIT_V(6); PG8_BAR;
    } else {
        PG8_STAGE(PG8_SB(0, 0), cB, voffB); PG8_STAGE(PG8_SA(0, 0), cA, voffA); PG8_STAGE(PG8_SB(0, 1), cB + hstep, voffB); PG8_STAGE(PG8_SA(0, 1), cA + hstep, voffA);
        if (wr == 1) PG8_BAR;
        PG8_WAIT_V(4); PG8_BAR;
        PG8_STAGE(PG8_SB(1, 0), cB + kstep, voffB); PG8_STAGE(PG8_SA(1, 0), cA + kstep, voffA); PG8_STAGE(PG8_SB(1, 1), cB + hstep + kstep, voffB);
        PG8_WAIT_V(6); PG8_BAR;
    }
    for (;;) {
        const bool has_next = S.next(ui + 1, nxt);
        const char* nA = has_next ? g.aptr(nxt) : cA; const char* nB = has_next ? g.bptr(nxt) : cB;
        for (int t = 0; t < nt; t += 2) {
            const bool last = (t == nt - 2);
            const char* a1 = cA + (size_t)(t + 1) * kstep;
            const char* a2 = last ? nA : cA + (size_t)(t + 2) * kstep; const char* b2 = last ? nB : cB + (size_t)(t + 2) * kstep;
            const char* a3 = a2 + kstep; const char* b3 = b2 + kstep;
            if (last && has_next) S.a_ready(nxt);
            if constexpr (SP2) {
            PG8_LDB(B0, 0, 0); PG8_LDB(B1, 0, 1); PG8_SCHED; PG8_LDA(At, 0, 0); PG8_STAGE(PG8_SA(1, 1), a1 + hstep, voffA);
            PG8_WAIT_V(8); PG8_WAIT_L(0); PG8_BAR; PG8_MMA(0, 0, At, B0); PG8_MMA(0, 1, At, B1); PG8_BAR; PG8_SCHED;
            PG8_LDA(At, 0, 1); PG8_STAGE(PG8_SB(0, 0), b2, voffB); PG8_STAGE(PG8_SB(0, 1), b2 + hstep, voffB); PG8_STAGE(PG8_SA(0, 0), a2, voffA);
            PG8_WAIT_V(8); PG8_WAIT_L(0); PG8_BAR; PG8_MMA(1, 0, At, B0); PG8_MMA(1, 1, At, B1); PG8_BAR; PG8_SCHED;
            PG8_LDB(B0, 1, 0); PG8_LDB(B1, 1, 1); PG8_SCHED; PG8_LDA(At, 1, 0); PG8_STAGE(PG8_SA(0, 1), a2 + hstep, voffA);
            PG8_WAIT_V(8); PG8_WAIT_L(0); PG8_BAR; PG8_MMA(0, 0, At, B0); PG8_MMA(0, 1, At, B1); PG8_BAR; PG8_SCHED;
            PG8_LDA(At, 1, 1); PG8_STAGE(PG8_SB(1, 0), b3, voffB); PG8_STAGE(PG8_SB(1, 1), b3 + hstep, voffB); PG8_STAGE(PG8_SA(1, 0), a3, voffA);
            PG8_WAIT_V(8); PG8_WAIT_L(0); PG8_BAR; PG8_MMA(1, 0, At, B0); PG8_MMA(1, 1, At, B1); PG8_BAR; PG8_SCHED;
            } else {
            PG8_LDB(B0, 0, 0); PG8_SCHED; PG8_LDA(At, 0, 0); PG8_STAGE(PG8_SA(1, 1), a1 + hstep, voffA);
            PG8_WAIT_L(8); PG8_BAR; PG8_WAIT_L(0); PG8_MMA(0, 0, At, B0); PG8_BAR; PG8_SCHED;
            PG8_LDB(B1, 0, 1); PG8_STAGE(PG8_SB(0, 0), b2, voffB);
            PG8_BAR; PG8_WAIT_L(0); PG8_MMA(0, 1, At, B1); PG8_BAR;
            PG8_LDA(At, 0, 1); PG8_STAGE(PG8_SA(0, 0), a2, voffA);
            PG8_BAR; PG8_WAIT_L(0); PG8_MMA(1, 0, At, B0); PG8_BAR; PG8_SCHED;
            PG8_STAGE(PG8_SB(0, 1), b2 + hstep, voffB);
            PG8_WAIT_V(6); PG8_BAR; PG8_MMA(1, 1, At, B1); PG8_BAR;
            PG8_LDB(B0, 1, 0); PG8_SCHED; PG8_LDA(At, 1, 0); PG8_STAGE(PG8_SA(0, 1), a2 + hstep, voffA);
            PG8_WAIT_L(8); PG8_BAR; PG8_WAIT_L(0); PG8_MMA(0, 0, At, B0); PG8_BAR; PG8_SCHED;
            PG8_LDB(B1, 1, 1); PG8_STAGE(PG8_SB(1, 0), b3, voffB);
            PG8_BAR; PG8_WAIT_L(0); PG8_MMA(0, 1, At, B1); PG8_BAR;
            PG8_LDA(At, 1, 1); PG8_STAGE(PG8_SA(1, 0), a3, voffA);
            PG8_BAR; PG8_WAIT_L(0); PG8_MMA(1, 0, At, B0); PG8_BAR; PG8_SCHED;
            PG8_STAGE(PG8_SB(1, 1), b3 + hstep, voffB);
            PG8_WAIT_V(6); PG8_BAR; PG8_MMA(1, 1, At, B1); PG8_BAR;
            }
        }
        if constexpr (ALIGN_EPI) { if (wr == 0) PG8_BAR; }
        if constexpr (!Epi::AFTER_DRAIN) { E(acc, cur, wr, wc, fr, fq); S.done(cur); }
        if (!has_next) break;
        if (nxt.seg == 0)
#pragma unroll
        for (int a = 0; a < 2; ++a)
#pragma unroll
            for (int b = 0; b < 2; ++b)
#pragma unroll
                for (int m = 0; m < 4; ++m)
#pragma unroll
                    for (int n = 0; n < 2; ++n) acc[a][b][m][n] = (f32x4){0.f, 0.f, 0.f, 0.f};
        cur = nxt; cA = nA; cB = nB; ++ui;
        if constexpr (ALIGN_EPI) { if (wr == 1) PG8_BAR; }
    }
    PG8_WAIT_V(0);
    if constexpr (!ALIGN_EPI) { if (wr == 0) PG8_BAR; }
    PG8_BAR;
    if constexpr (Epi::AFTER_DRAIN) { E.fused(acc, cur, wr, wc, fr, fq, lds, wid, lane); S.done(cur); }
#undef PG8_SA
#undef PG8_SB
#undef PG8_STAGE
#undef PG8_LDA
#undef PG8_LDB
#undef PG8_MMA
#undef PG8_WAIT_V
#undef PG8_WAIT_L
#undef PG8_BAR
#undef PG8_SCHED
}
}


namespace att {
using s16x4 = __attribute__((ext_vector_type(4))) short;
using f32x16 = __attribute__((ext_vector_type(16))) float;
#define KSWZ(row, colB) ((row) * 256 + ((colB) ^ (((row) & 7) << 4)))
#define SBAR() __builtin_amdgcn_sched_barrier(0)
__device__ __forceinline__ int crow(int r, int hi) { return (r & 3) + 8 * (r >> 2) + 4 * hi; }
__device__ __forceinline__ unsigned cvtpk(float lo, float hi) { unsigned r; asm volatile("v_cvt_pk_bf16_f32 %0, %1, %2" : "=v"(r) : "v"(lo), "v"(hi)); return r; }
__device__ __forceinline__ int v_st(int k, int c) { const int kk = (k & ~0xC) | ((k & 4) << 1) | ((k & 8) >> 1); return ((kk >> 3) * 4 + (c >> 5)) * 512 + ((kk & 7) * 32 + (c & 31)) * 2; }
__device__ __forceinline__ int v_rd_base(int lane) { return ((lane & 3) << 3) | (((lane >> 2) & 3) << 6) | (((lane >> 4) & 1) << 5) | (((lane >> 5) & 1) << 8); }
constexpr int v_rd_off(int d0, int ks, int half) { return d0 * 512 + ks * 4096 + half * 2048; }
template <int OFF> __device__ __forceinline__ s16x4 tr_read(int vb) { s16x4 r; asm volatile("ds_read_b64_tr_b16 %0, %1 offset:%2" : "=&v"(r) : "v"(vb), "i"(OFF) : "memory"); return r; }
#define ATT_PK(L, H) (bf16x8){L[0], L[1], L[2], L[3], H[0], H[1], H[2], H[3]}
template <int D0> __device__ __forceinline__ void frag4(int vb, bf16x8& f0, bf16x8& f1, bf16x8& f2, bf16x8& f3) {
    const s16x4 l0 = tr_read<v_rd_off(D0, 0, 0)>(vb), h0 = tr_read<v_rd_off(D0, 0, 1)>(vb), l1 = tr_read<v_rd_off(D0, 1, 0)>(vb), h1 = tr_read<v_rd_off(D0, 1, 1)>(vb);
    const s16x4 l2 = tr_read<v_rd_off(D0, 2, 0)>(vb), h2 = tr_read<v_rd_off(D0, 2, 1)>(vb), l3 = tr_read<v_rd_off(D0, 3, 0)>(vb), h3 = tr_read<v_rd_off(D0, 3, 1)>(vb);
    asm volatile("s_waitcnt lgkmcnt(0)" ::: "memory"); SBAR();
    f0 = ATT_PK(l0, h0); f1 = ATT_PK(l1, h1); f2 = ATT_PK(l2, h2); f3 = ATT_PK(l3, h3);
}
template <int D0> __device__ __forceinline__ void pv_one(f32x16& od, int vb, bf16x8 pa0, bf16x8 pa1, bf16x8 pa2, bf16x8 pa3) {
    bf16x8 f0, f1, f2, f3; frag4<D0>(vb, f0, f1, f2, f3);
    od = __builtin_amdgcn_mfma_f32_32x32x16_bf16(pa0, f0, od, 0, 0, 0);
    od = __builtin_amdgcn_mfma_f32_32x32x16_bf16(pa1, f1, od, 0, 0, 0);
    od = __builtin_amdgcn_mfma_f32_32x32x16_bf16(pa2, f2, od, 0, 0, 0);
    od = __builtin_amdgcn_mfma_f32_32x32x16_bf16(pa3, f3, od, 0, 0, 0);
}
__device__ __forceinline__ void qkt(f32x16& p0, f32x16& p1, const char* Ks, const bf16x8* qr, int r32, int hi) {
#pragma unroll
    for (int d0 = 0; d0 < 8; ++d0) { const int cb = (d0 * 16 + hi * 8) * 2;
        const bf16x8 b0 = *reinterpret_cast<const bf16x8*>(Ks + KSWZ(r32, cb));
        const bf16x8 b1 = *reinterpret_cast<const bf16x8*>(Ks + KSWZ(32 + r32, cb));
        p0 = __builtin_amdgcn_mfma_f32_32x32x16_bf16(b0, qr[d0], p0, 0, 0, 0);
        p1 = __builtin_amdgcn_mfma_f32_32x32x16_bf16(b1, qr[d0], p1, 0, 0, 0); }
}
__device__ __forceinline__ void pack_p(const f32x16& p0, const f32x16& p1, bf16x8& pa0, bf16x8& pa1, bf16x8& pa2, bf16x8& pa3) {
#define ATT_PK4(P, BASE, OUT) do { unsigned a0 = cvtpk(P[BASE + 0], P[BASE + 1]), a1 = cvtpk(P[BASE + 2], P[BASE + 3]);   \
    unsigned b0 = cvtpk(P[BASE + 4], P[BASE + 5]), b1 = cvtpk(P[BASE + 6], P[BASE + 7]);                              \
    auto r0 = __builtin_amdgcn_permlane32_swap(a0, b0, false, false); auto r1 = __builtin_amdgcn_permlane32_swap(a1, b1, false, false); \
    u32x4 w = {r0[0], r1[0], r0[1], r1[1]}; OUT = *reinterpret_cast<bf16x8*>(&w); } while (0)
    ATT_PK4(p0, 0, pa0); ATT_PK4(p0, 8, pa1); ATT_PK4(p1, 0, pa2); ATT_PK4(p1, 8, pa3);
#undef ATT_PK4
}
__device__ __forceinline__ float swap_max(float v) { auto rr = __builtin_amdgcn_permlane32_swap(__float_as_uint(v), __float_as_uint(v), false, false); return fmaxf(__uint_as_float(rr[0]), __uint_as_float(rr[1])); }
__device__ __forceinline__ float swap_add(float v) { auto rr = __builtin_amdgcn_permlane32_swap(__float_as_uint(v), __float_as_uint(v), false, false); return __uint_as_float(rr[0]) + __uint_as_float(rr[1]); }

constexpr float SCALE = 0.088388347648318440f, SQ = 11.313708498984761f, CL2 = SCALE * 1.4426950408889634f;
__device__ __forceinline__ void phase_attn(const Ptrs& p, unsigned char* lds, int wid_) {
    const int wid = wid_, lane = lane_id(), tid = wid * 64 + lane, r32 = lane & 31, hi = lane >> 5;
    char* V_lds = (char*)lds; char* K_lds = (char*)lds + 32768;
    float* wsf = (float*)(lds + 65536) + wid * 64; float* biasR = (float*)(lds + 65536 + 2048);
    const bf16* P = (const bf16*)(p.ws + WS_PROJ); bf16* HA = (bf16*)(p.ws + WS_HA);
    const int sr = tid >> 4, sc = (tid & 15) * 8, vst0 = v_st(sr, sc), vst1 = v_st(32 + sr, sc);
    const int vb0 = (int)(uintptr_t)V_lds + v_rd_base(lane);
    for (int unit = blockIdx.x; unit < AH * (S / 256); unit += gridDim.x) {
        const int h = unit & 7, u = unit >> 3;
        __syncthreads();
        if (tid < 320) { const int e = 319 - tid; biasR[tid] = SQ * p.in[8][h * 257 + (e > 256 ? 256 : e)]; }
        bf16x8 qr[8];
        { const bf16* Qw = P + (size_t)(256 * u + 32 * wid + r32) * NP + C_AQ + h * 128 + hi * 8;
#pragma unroll
          for (int d0 = 0; d0 < 8; ++d0) qr[d0] = *(const bf16x8*)(Qw + d0 * 16); }
        const int qi = wid >> 1, qin = 32 * (wid & 1) + r32;
        const int j0 = (8 - 4 * u) > 0 ? (8 - 4 * u) : 0;
        const bf16* Kg = P + C_AK + h * 128 + sc; const bf16* Vg = P + C_AV + h * 128 + sc;
        bf16x8 vs0, vs1, ks0, ks1;
#define ASLOAD(j) do { const size_t r0_ = (size_t)((4 * u - 8 + (j)) * 64 + sr) * NP; vs0 = *(const bf16x8*)(Vg + r0_); vs1 = *(const bf16x8*)(Vg + r0_ + (size_t)32 * NP); \
        ks0 = *(const bf16x8*)(Kg + r0_); ks1 = *(const bf16x8*)(Kg + r0_ + (size_t)32 * NP); } while (0)
#define ASWRITE(b) do { *(bf16x8*)(V_lds + (b) * 16384 + vst0) = vs0; *(bf16x8*)(V_lds + (b) * 16384 + vst1) = vs1; const int kc_ = sc * 2; \
        *(bf16x8*)(K_lds + (b) * 16384 + KSWZ(sr, kc_)) = ks0; *(bf16x8*)(K_lds + (b) * 16384 + KSWZ(32 + sr, kc_)) = ks1; } while (0)
        ASLOAD(j0); ASWRITE(0);
        __syncthreads();
        float m_reg = -1e30f, l_reg = 0.f; f32x16 o[4];
#pragma unroll
        for (int d = 0; d < 4; ++d)
#pragma unroll
            for (int r = 0; r < 16; ++r) o[d][r] = 0.f;
        for (int j = j0; j < 12; ++j) {
            const int cur = (j - j0) & 1;
            if (j + 1 < 12) ASLOAD(j + 1);
            if (j >= qi && j <= qi + 8) {
                const int dlt = qi + 8 - j;
                f32x16 p0, p1;
                if (dlt >= 3) { const float cf = biasR[0];
#pragma unroll
                    for (int r = 0; r < 16; ++r) { p0[r] = cf; p1[r] = cf; } }
                else { const float* bp = biasR + (191 - qin - 64 * dlt + 4 * hi);
#pragma unroll
                    for (int r = 0; r < 16; ++r) { p0[r] = bp[(r & 3) + 8 * (r >> 2)]; p1[r] = bp[32 + (r & 3) + 8 * (r >> 2)]; } }
                qkt(p0, p1, K_lds + cur * 16384, qr, r32, hi);
                float pmax = p0[0];
#pragma unroll
                for (int r = 1; r < 16; ++r) pmax = fmaxf(pmax, p0[r]);
#pragma unroll
                for (int r = 0; r < 16; ++r) pmax = fmaxf(pmax, p1[r]);
                pmax = swap_max(pmax);
                const float mn = fmaxf(m_reg, pmax), alpha = __builtin_amdgcn_exp2f((m_reg - mn) * CL2); m_reg = mn;
                const float mnC = -mn * CL2; float ps = 0.f;
#pragma unroll
                for (int r = 0; r < 16; ++r) { p0[r] = __builtin_amdgcn_exp2f(fmaf(p0[r], CL2, mnC)); p1[r] = __builtin_amdgcn_exp2f(fmaf(p1[r], CL2, mnC)); ps += p0[r] + p1[r]; }
                ps = swap_add(ps); l_reg = l_reg * alpha + ps;
                if (__any(alpha < 1.f)) { if (hi == 0) wsf[r32] = alpha; asm volatile("s_waitcnt lgkmcnt(0)" ::: "memory");
#pragma unroll
                    for (int d = 0; d < 4; ++d)
#pragma unroll
                        for (int r = 0; r < 16; ++r) o[d][r] *= wsf[crow(r, hi)]; }
                bf16x8 pa0, pa1, pa2, pa3; pack_p(p0, p1, pa0, pa1, pa2, pa3);
                const int vb = vb0 + cur * 16384;
                pv_one<0>(o[0], vb, pa0, pa1, pa2, pa3); pv_one<1>(o[1], vb, pa0, pa1, pa2, pa3); pv_one<2>(o[2], vb, pa0, pa1, pa2, pa3); pv_one<3>(o[3], vb, pa0, pa1, pa2, pa3);
            }
            if (j + 1 < 12) ASWRITE(cur ^ 1);
            __syncthreads();
        }
#undef ASLOAD
#undef ASWRITE
        if (hi == 0) wsf[32 + r32] = l_reg; asm volatile("s_waitcnt lgkmcnt(0)" ::: "memory");
        bf16* Ow = HA + (size_t)(256 * u + 32 * wid) * 1024 + h * 128 + r32;
#pragma unroll
        for (int r = 0; r < 16; ++r) { const int orow = crow(r, hi); const float rl = __builtin_amdgcn_rcpf(wsf[32 + orow]);
#pragma unroll
            for (int d0 = 0; d0 < 4; ++d0) Ow[(size_t)orow * 1024 + d0 * 32] = (bf16)f2bf(o[d0][r] * rl); }
    }
}
}
using att::v_rd_base;

__device__ __forceinline__ void phase_mlstm_local(const Ptrs& p, unsigned char* lds, int wid_) {
    const int wid = wid_, lane = lane_id(), tid = wid * 64 + lane, r32 = lane & 31, hi = lane >> 5;
    char* WK_lds = (char*)lds; char* V_lds = (char*)lds + 16384; float* gsh = (float*)(lds + 49152);
    const bf16* P = (const bf16*)(p.ws + WS_PROJ); bf16* QC = (bf16*)(p.ws + WS_QC); bf16* KC = (bf16*)(p.ws + WS_KC);
    const float* cw = p.in[3]; const float* cb = p.in[4];
    const float* LI = (const float*)(p.ws + WS_LI); const float* LF = (const float*)(p.ws + WS_LF);
    const int vbK = (int)(uintptr_t)WK_lds + v_rd_base(lane), vbV = (int)(uintptr_t)V_lds + v_rd_base(lane);
    for (int unit = blockIdx.x; unit < NCH * MH; unit += gridDim.x) {
        const int c = unit & 127, h = unit >> 7, t0 = c * 64;
        __syncthreads();
        { float b = LF[h * S + t0 + lane];
#pragma unroll
          for (int o = 1; o < 64; o <<= 1) { const float v = __shfl_up(b, o); if (lane >= o) b += v; }
          const float btot = __shfl(b, 63), wl = btot - b + LI[h * S + t0 + lane], m = wave_max(wl), wgt = __expf(wl - m);
          if (wid == 0) { gsh[lane] = wgt; if (lane == 0) { ((float*)(p.ws + WS_MLOC))[h * 128 + c] = m; ((float*)(p.ws + WS_BTOT))[h * 128 + c] = btot; } } }
        __syncthreads();
        { const int t = tid >> 3, cg = tid & 7; const float wgt = gsh[t];
#pragma unroll
          for (int which = 0; which < 2; ++which)
#pragma unroll
              for (int blk = 0; blk < 2; ++blk) { const int ch = cg * 16 + blk * 8, gch = which * 512 + h * 128 + ch;
                  float y[8];
                  { const f32x4 b0 = *(const f32x4*)(cb + gch), b1 = *(const f32x4*)(cb + gch + 4); y[0] = b0[0]; y[1] = b0[1]; y[2] = b0[2]; y[3] = b0[3]; y[4] = b1[0]; y[5] = b1[1]; y[6] = b1[2]; y[7] = b1[3]; }
#pragma unroll
                  for (int tap = 0; tap < 4; ++tap) { const int tt = t0 + t - 3 + tap;
                      if (tt >= 0) { const bf16x8 xv = *(const bf16x8*)(P + (size_t)tt * NP + gch); const f32x4 w0 = *(const f32x4*)(cw + tap * 1024 + gch), w1 = *(const f32x4*)(cw + tap * 1024 + gch + 4);
#pragma unroll
                          for (int e = 0; e < 8; ++e) y[e] += (e < 4 ? w0[e & 3] : w1[e & 3]) * bf2f((unsigned short)xv[e]); } }
#pragma unroll
                  for (int e = 0; e < 8; ++e) y[e] = y[e] * sigmoidf_(y[e]);
                  if (which == 0) { *(u32x4*)(QC + (size_t)(t0 + t) * 512 + h * 128 + ch) = (u32x4){pk2(y[0], y[1]), pk2(y[2], y[3]), pk2(y[4], y[5]), pk2(y[6], y[7])}; }
                  else {
#pragma unroll
                      for (int e = 0; e < 8; ++e) y[e] *= att::SCALE;
                      const u32x4 kb = (u32x4){pk2(y[0], y[1]), pk2(y[2], y[3]), pk2(y[4], y[5]), pk2(y[6], y[7])};
                      *(u32x4*)(KC + (size_t)(t0 + t) * 512 + h * 128 + ch) = kb;
                      u32x4 wk;
#pragma unroll
                      for (int e = 0; e < 4; ++e) { const float lo = __builtin_bit_cast(float, kb[e] << 16) * wgt, hi2 = __builtin_bit_cast(float, kb[e] & 0xffff0000u) * wgt; wk[e] = pk2(lo, hi2); }
                      *(u32x4*)(WK_lds + att::v_st(t, ch)) = wk; } }
#pragma unroll
          for (int i = 0; i < 4; ++i) { const int idx = tid + NTHR * i, tv = idx >> 5, c8 = (idx & 31) * 8;
              *(bf16x8*)(V_lds + (c8 >> 7) * 16384 + att::v_st(tv, c8 & 127)) = *(const bf16x8*)(P + (size_t)(t0 + tv) * NP + C_MV + h * 256 + c8); } }
        __syncthreads();
        { bf16x8 a0, a1, a2, a3; att::frag4<0>(vbV + (wid >> 2) * 16384 + (wid & 3) * 512, a0, a1, a2, a3);
          float* CLw = p.out + ((size_t)(h * 128 + c) * 256 + 32 * wid) * 128 + r32;
#pragma unroll
          for (int dkb = 0; dkb < 4; ++dkb) { bf16x8 b0, b1, b2, b3; att::frag4<0>(vbK + dkb * 512, b0, b1, b2, b3);
              att::f32x16 acc;
#pragma unroll
              for (int r = 0; r < 16; ++r) acc[r] = 0.f;
              acc = __builtin_amdgcn_mfma_f32_32x32x16_bf16(a0, b0, acc, 0, 0, 0); acc = __builtin_amdgcn_mfma_f32_32x32x16_bf16(a1, b1, acc, 0, 0, 0);
              acc = __builtin_amdgcn_mfma_f32_32x32x16_bf16(a2, b2, acc, 0, 0, 0); acc = __builtin_amdgcn_mfma_f32_32x32x16_bf16(a3, b3, acc, 0, 0, 0);
#pragma unroll
              for (int r = 0; r < 16; ++r) CLw[(size_t)att::crow(r, hi) * 128 + dkb * 32] = acc[r]; } }
        if (tid < 128) { float sum = 0.f;
#pragma unroll 8
            for (int t = 0; t < 64; ++t) sum += bf2f(*(const unsigned short*)(WK_lds + att::v_st(t, tid)));
            ((float*)(p.ws + WS_NLOC))[(h * 128 + c) * 128 + tid] = sum; }
    }
}

__device__ __forceinline__ void phase_mlstm_out(const Ptrs& p, unsigned char* lds, int wid_) {
    const int wid = wid_, lane = lane_id(), tid = wid * 64 + lane, r32 = lane & 31, hi = lane >> 5, thalf = wid >> 2, dvq = wid & 3;
    char* K_lds = (char*)lds; char* V_lds = (char*)lds + 16384;
    float* bsh = (float*)(lds + 49152); float* lish = bsh + 64; float* nsh = lish + 64; float* rss = nsh + 128; float* wsf = rss + 256 + wid * 64;
    const bf16* P = (const bf16*)(p.ws + WS_PROJ); const bf16* QC = (const bf16*)(p.ws + WS_QC); const bf16* KC = (const bf16*)(p.ws + WS_KC);
    const float* LI = (const float*)(p.ws + WS_LI); const float* LF = (const float*)(p.ws + WS_LF);
    bf16* HM = (bf16*)(p.ws + WS_HM);
    const int vb = (int)(uintptr_t)V_lds + (dvq >> 1) * 16384 + (2 * (dvq & 1)) * 512 + att::v_rd_base(lane);
    for (int unit = blockIdx.x; unit < NCH * MH; unit += gridDim.x) {
        const int c = unit & 127, h = unit >> 7, t0 = c * 64;
        __syncthreads();
        { const int sr = tid >> 4, sc = (tid & 15) * 8;
          *(bf16x8*)(K_lds + KSWZ(sr, sc * 2)) = *(const bf16x8*)(KC + (size_t)(t0 + sr) * 512 + h * 128 + sc);
          *(bf16x8*)(K_lds + KSWZ(32 + sr, sc * 2)) = *(const bf16x8*)(KC + (size_t)(t0 + 32 + sr) * 512 + h * 128 + sc);
#pragma unroll
          for (int i = 0; i < 4; ++i) { const int idx = tid + NTHR * i, tv = idx >> 5, c8 = (idx & 31) * 8;
              *(bf16x8*)(V_lds + (c8 >> 7) * 16384 + att::v_st(tv, c8 & 127)) = *(const bf16x8*)(P + (size_t)(t0 + tv) * NP + C_MV + h * 256 + c8); } }
        if (wid == 0) { float b = LF[h * S + t0 + lane];
#pragma unroll
            for (int o = 1; o < 64; o <<= 1) { const float v = __shfl_up(b, o); if (lane >= o) b += v; }
            bsh[lane] = b; lish[lane] = LI[h * S + t0 + lane]; }
        if (wid == 1) { const float* np = (const float*)(p.ws + WS_NPREV) + (h * 128 + c) * 128; nsh[lane] = np[lane]; nsh[64 + lane] = np[64 + lane]; }
        bf16x8 qr[8];
        { const bf16* Qw = QC + (size_t)(t0 + 32 * thalf + r32) * 512 + h * 128 + hi * 8;
#pragma unroll
          for (int d0 = 0; d0 < 8; ++d0) qr[d0] = *(const bf16x8*)(Qw + d0 * 16); }
        __syncthreads();
        const float mprev = ((const float*)(p.ws + WS_MPREV))[h * 128 + c];
        att::f32x16 p0, p1;
#pragma unroll
        for (int r = 0; r < 16; ++r) { p0[r] = 0.f; p1[r] = 0.f; }
        att::qkt(p0, p1, K_lds, qr, r32, hi);
        const int t = 32 * thalf + r32; const float bt = bsh[t];
        float mt = bt + mprev;
#pragma unroll
        for (int r = 0; r < 16; ++r) { const int s0 = att::crow(r, hi), s1 = 32 + s0;
            if (s0 <= t) mt = fmaxf(mt, bt - bsh[s0] + lish[s0]);
            if (s1 <= t) mt = fmaxf(mt, bt - bsh[s1] + lish[s1]); }
        mt = att::swap_max(mt);
        float psum = 0.f;
#pragma unroll
        for (int r = 0; r < 16; ++r) { const int s0 = att::crow(r, hi), s1 = 32 + s0;
            p0[r] = (s0 <= t) ? __expf(bt - bsh[s0] + lish[s0] - mt) * p0[r] : 0.f;
            p1[r] = (s1 <= t) ? __expf(bt - bsh[s1] + lish[s1] - mt) * p1[r] : 0.f; psum += p0[r] + p1[r]; }
        psum = att::swap_add(psum);
        float qn = 0.f;
#pragma unroll
        for (int d0 = 0; d0 < 8; ++d0) { const f32x4 n0 = *(const f32x4*)(nsh + 16 * d0 + 8 * hi), n1 = *(const f32x4*)(nsh + 16 * d0 + 8 * hi + 4);
#pragma unroll
            for (int e = 0; e < 8; ++e) qn += bf2f((unsigned short)qr[d0][e]) * (e < 4 ? n0[e & 3] : n1[e & 3]); }
        qn = att::swap_add(qn);
        { const float ai = __expf(bt + mprev - mt), den = psum + ai * qn, inv = 1.f / fmaxf(fabsf(den), __expf(-mt));
          if (hi == 0) { wsf[r32] = ai; wsf[32 + r32] = inv; } }
        bf16x8 pa0, pa1, pa2, pa3; att::pack_p(p0, p1, pa0, pa1, pa2, pa3);
        att::f32x16 oi[2], oc[2];
#pragma unroll
        for (int b = 0; b < 2; ++b)
#pragma unroll
            for (int r = 0; r < 16; ++r) { oi[b][r] = 0.f; oc[b][r] = 0.f; }
        att::pv_one<0>(oi[0], vb, pa0, pa1, pa2, pa3); att::pv_one<0>(oi[1], vb + 512, pa0, pa1, pa2, pa3);
#pragma unroll
        for (int b = 0; b < 2; ++b) { const float* cp = p.out + ((size_t)(h * 128 + c) * 256 + 64 * dvq + 32 * b + r32) * 128 + 8 * hi;
#pragma unroll
            for (int ks = 0; ks < 8; ++ks) { const f32x4 c0 = *(const f32x4*)(cp + 16 * ks), c1 = *(const f32x4*)(cp + 16 * ks + 4);
                const u32x4 w = (u32x4){att::cvtpk(c0[0], c0[1]), att::cvtpk(c0[2], c0[3]), att::cvtpk(c1[0], c1[1]), att::cvtpk(c1[2], c1[3])};
                oc[b] = __builtin_amdgcn_mfma_f32_32x32x16_bf16(qr[ks], __builtin_bit_cast(bf16x8, w), oc[b], 0, 0, 0); } }
        asm volatile("s_waitcnt lgkmcnt(0)" ::: "memory");
        float ssr[16];
#pragma unroll
        for (int r = 0; r < 16; ++r) { const int row = att::crow(r, hi); const float a = wsf[row], iv = wsf[32 + row];
            oi[0][r] = (oi[0][r] + a * oc[0][r]) * iv; oi[1][r] = (oi[1][r] + a * oc[1][r]) * iv;
            float ss = oi[0][r] * oi[0][r] + oi[1][r] * oi[1][r];
            ss += __shfl_xor(ss, 1); ss += __shfl_xor(ss, 2); ss += __shfl_xor(ss, 4); ss += __shfl_xor(ss, 8); ss += __shfl_xor(ss, 16);
            ssr[r] = ss; }
        if (r32 == 0) {
#pragma unroll
            for (int r = 0; r < 16; ++r) rss[(thalf * 4 + dvq) * 32 + att::crow(r, hi)] = ssr[r]; }
        __syncthreads();
        { const float mn0 = p.in[7][h * 256 + 64 * dvq + r32], mn1 = p.in[7][h * 256 + 64 * dvq + 32 + r32];
#pragma unroll
          for (int r = 0; r < 16; ++r) { const int row = att::crow(r, hi);
              const float ss = (rss[(thalf * 4 + 0) * 32 + row] + rss[(thalf * 4 + 1) * 32 + row]) + (rss[(thalf * 4 + 2) * 32 + row] + rss[(thalf * 4 + 3) * 32 + row]);
              const float rn = rsqrtf(ss * (1.f / 256.f) + EPS); const size_t tr = (size_t)(t0 + 32 * thalf + row);
              const float o0 = bf2f(P[tr * NP + C_MO + h * 256 + 64 * dvq + r32]), o1 = bf2f(P[tr * NP + C_MO + h * 256 + 64 * dvq + 32 + r32]);
              HM[tr * 1024 + h * 256 + 64 * dvq + r32] = (bf16)f2bf(oi[0][r] * rn * mn0 * sigmoidf_(o0));
              HM[tr * 1024 + h * 256 + 64 * dvq + 32 + r32] = (bf16)f2bf(oi[1][r] * rn * mn1 * sigmoidf_(o1)); } }
    }
}


#define XB_TMO      128
#define XB_XCNT(j)  (256  + 64 * (j))
#define XB_XSUB(j)  (1280 + 64 * (j))
#define XB_XGEN(j)  (2304 + 64 * (j))
#define XB_TOP      3328
#define XB_TOPGEN   3392
#define XCD_BAR_WORDS 3456
#define XB_SPIN_CAP (1u << 18)
__device__ __forceinline__ unsigned xb_ld(unsigned* p)              { return __hip_atomic_load(p, __ATOMIC_RELAXED, __HIP_MEMORY_SCOPE_AGENT); }
__device__ __forceinline__ unsigned xb_add(unsigned* p, unsigned v) { return __hip_atomic_fetch_add(p, v, __ATOMIC_RELAXED, __HIP_MEMORY_SCOPE_AGENT); }
__device__ __forceinline__ unsigned xb_xcc_id() { return (unsigned)__builtin_amdgcn_s_getreg((3 << 11) | 20) & 0xFu; }
#define XB_SPIN(cond, bar) do { unsigned _sp = 0; while (cond) { __builtin_amdgcn_s_sleep(1); \
    if ((++_sp & 255u) == 0u) { if (xb_ld(&(bar)[XB_TMO])) break; if (_sp > XB_SPIN_CAP) { atomicAdd(&(bar)[XB_TMO], 1u); break; } } } } while (0)
struct XcdBarrier { unsigned* bar; unsigned x; volatile __attribute__((address_space(3))) unsigned* st; };
__device__ __forceinline__ void xcd_barrier_complete(unsigned* bar, unsigned x, unsigned& nloc, unsigned& nx) {
    const unsigned G = gridDim.x * gridDim.y * gridDim.z;
    unsigned sum, cnt, mine, sp = 0u;
    for (;;) {
        sum = 0u; cnt = 0u; mine = 0u;
#pragma unroll
        for (unsigned j = 0; j < 16; ++j) { const unsigned c = xb_ld(&bar[XB_XCNT(j)]); sum += c; cnt += (c > 0u) ? 1u : 0u; mine = (j == x) ? c : mine; }
        if (sum == G) break;
        __builtin_amdgcn_s_sleep(1);
        if ((++sp & 255u) == 0u) { if (xb_ld(&bar[XB_TMO])) break; if (sp > XB_SPIN_CAP) { atomicAdd(&bar[XB_TMO], 1u); break; } }
    }
    nloc = mine > 0u ? mine : 1u; nx = cnt > 0u ? cnt : 1u;
}
__device__ __forceinline__ void xcd_barrier(const XcdBarrier& b, bool leader) {
    asm volatile("s_waitcnt vmcnt(0)" ::: "memory");
    __syncthreads();
    if (leader) {
        unsigned* bar = b.bar;
        __builtin_amdgcn_s_waitcnt(0);
        unsigned nloc = b.st[0], nx = b.st[1];
        if (nloc == 0u) { xcd_barrier_complete(bar, b.x, nloc, nx); b.st[0] = nloc; b.st[1] = nx; }
        const unsigned old = xb_add(&bar[XB_XSUB(b.x)], 1u);
        const unsigned gen = old / nloc;
        if (old + 1u == (gen + 1u) * nloc) {
            __builtin_amdgcn_fence(__ATOMIC_RELEASE, "agent");
            asm volatile("s_waitcnt vmcnt(0)" ::: "memory");
            const unsigned og = xb_add(&bar[XB_TOP], 1u);
            const unsigned tg = og / nx;
            if (og + 1u == (tg + 1u) * nx) xb_add(&bar[XB_TOPGEN], 1u);
            else XB_SPIN(xb_ld(&bar[XB_TOPGEN]) == tg, bar);
            __builtin_amdgcn_fence(__ATOMIC_ACQUIRE, "agent");
            xb_add(&bar[XB_XGEN(b.x)], 1u);
            asm volatile("s_waitcnt vmcnt(0)" ::: "memory");
        } else {
            XB_SPIN(xb_ld(&bar[XB_XGEN(b.x)]) == gen, bar);
            __builtin_amdgcn_fence(__ATOMIC_ACQUIRE, "agent");
            asm volatile("s_waitcnt vmcnt(0)" ::: "memory");
        }
    }
    __syncthreads();
}

__global__ void __launch_bounds__(NTHR, 2) mega(Ptrs p) {
    extern __shared__ __attribute__((aligned(16))) unsigned char lds[];
    cg::grid_group grid = cg::this_grid();
    const int WID = __builtin_amdgcn_readfirstlane((int)threadIdx.x >> 6);
    unsigned char* ws = p.ws;
    XcdBarrier xbar; xbar.bar = (unsigned*)(ws + WS_CTL); xbar.x = xb_xcc_id(); xbar.st = (volatile __attribute__((address_space(3))) unsigned*)(lds + 131072);
    if (threadIdx.x == 0) { xbar.st[0] = 0u; xbar.st[1] = 0u; (void)xb_add(&xbar.bar[XB_XCNT(xbar.x)], 1u); }
    if (ws == nullptr) grid.sync();
#define GRID_BAR() xcd_barrier(xbar, WID == 0 && lane_id() == 0)
    bf16* WIN = (bf16*)(ws + WS_WIN); bf16* XN = (bf16*)(ws + WS_XN); bf16* PROJ = (bf16*)(ws + WS_PROJ);
    bf16* WM = (bf16*)(ws + WS_WM); bf16* WA = (bf16*)(ws + WS_WA); bf16* WO = (bf16*)(ws + WS_WO); bf16* WUP = (bf16*)(ws + WS_WUP); bf16* WDN = (bf16*)(ws + WS_WDN);
    bf16* HM = (bf16*)(ws + WS_HM); bf16* HA = (bf16*)(ws + WS_HA); bf16* MRG = (bf16*)(ws + WS_MRG); bf16* A2 = (bf16*)(ws + WS_A2); bf16* U = (bf16*)(ws + WS_U); bf16* ACT = (bf16*)(ws + WS_ACT);
#define PH_T   phase_transpose(p, lds, WID); __syncthreads();
#define PH_NG  phase_norm_gates(p, lds, WID);
#define PH_1   { pg8::Gemm g{XN, WIN, nullptr, nullptr, D}; pg8::StaticOrder So; So.init(S, NP, gridDim.x, blockIdx.x); pg8::EpiBf16 E{PROJ, NP}; \
      pg8::gemm_phase<pg8::EpiBf16, pg8::StaticOrder, true, true>((PG8_LAS unsigned char*)lds, g, So, E, WID); }
#define PH_2A  att::phase_attn(p, lds, WID); __syncthreads();
#define PH_2B  phase_mlstm_local(p, lds, WID);
#define PH_3   phase_scan(p, WID);
#define PH_4   phase_mlstm_out(p, lds, WID);
#define PH_5   { pg8::Gemm g{HM, WM, HA, WA, 1024}; pg8::StaticOrder So; So.init(S, D, gridDim.x, blockIdx.x, 2); pg8::EpiMerge E{PROJ, p.in[9], MRG}; \
      pg8::gemm_phase<pg8::EpiMerge, pg8::StaticOrder, true, true>((PG8_LAS unsigned char*)lds, g, So, E, WID); }
#define PH_6   { pg8::Gemm g{MRG, WO, nullptr, nullptr, D}; pg8::StaticOrder So; So.init(S, D, gridDim.x, blockIdx.x); pg8::EpiResid1 E{p.in[0], p.out, A2, p.in[13], (float*)(ws + WS_SLAB)}; \
      pg8::gemm_phase<pg8::EpiResid1, pg8::StaticOrder, false, true>((PG8_LAS unsigned char*)lds, g, So, E, WID); }
#define PH_7   { phase_rowstat(p, WID); pg8::Gemm g{A2, WUP, nullptr, nullptr, D}; pg8::StaticOrder So; So.init(S, NUP, gridDim.x, blockIdx.x); pg8::EpiBf16 E{U, NUP}; \
      pg8::gemm_phase<pg8::EpiBf16, pg8::StaticOrder, true, true>((PG8_LAS unsigned char*)lds, g, So, E, WID); }
#define PH_8   phase_ffn_conv(p, WID);
#define PH_9(dst)   { pg8::Gemm g{ACT, WDN, nullptr, nullptr, DFF}; pg8::StaticOrder So; So.init(S, D, gridDim.x, blockIdx.x); pg8::EpiResid2 E{dst}; \
      pg8::gemm_phase<pg8::EpiResid2, pg8::StaticOrder, false, true>((PG8_LAS unsigned char*)lds, g, So, E, WID); }
#define PH_10  phase_final_norm(p, WID);
#ifndef DUP
#define DUP -1
#endif
    PH_T if (DUP == 0) { PH_T }
    PH_NG if (DUP == 1) { __syncthreads(); PH_NG }
    GRID_BAR();
    PH_1 if (DUP == 2) { PH_1 }
    GRID_BAR();
    PH_2A if (DUP == 3) { PH_2A }
    PH_2B if (DUP == 4) { __syncthreads(); PH_2B }
    GRID_BAR();
    PH_3
    GRID_BAR();
    PH_4 if (DUP == 5) { __syncthreads(); PH_4 }
    GRID_BAR();
    PH_5 if (DUP == 6) { PH_5 }
    GRID_BAR();
    PH_6 if (DUP == 7) { PH_6 }
    GRID_BAR();
    PH_7 if (DUP == 8) { PH_7 }
    GRID_BAR();
    PH_8 if (DUP == 9) { PH_8 }
    GRID_BAR();
    if (DUP == 10) { PH_9((float*)(ws + WS_U)) }
    PH_9(p.out)
    GRID_BAR();
    PH_10
    if (DUP == 11) { GRID_BAR(); GRID_BAR(); GRID_BAR(); GRID_BAR(); GRID_BAR(); GRID_BAR(); GRID_BAR(); GRID_BAR(); GRID_BAR(); GRID_BAR(); }
}

extern "C" void kernel_launch(void* const* d_in, const int* in_sizes, int n_in, void* d_out, int out_size, void* d_ws, size_t ws_size, hipStream_t stream) {
    static int grid_blocks = 0;
    if (grid_blocks == 0) {
        if (n_in != 19 || out_size != S * D || ws_size < WS_END) { fprintf(stderr, "kernel_launch: unexpected shapes n_in %d out %d ws %zu\n", n_in, out_size, ws_size); grid_blocks = -1; return; }
        int dev = 0, cus = 0, per_cu = 0;
        (void)hipGetDevice(&dev);
        (void)hipDeviceGetAttribute(&cus, hipDeviceAttributeMultiprocessorCount, dev);
        (void)hipFuncSetAttribute((const void*)mega, hipFuncAttributeMaxDynamicSharedMemorySize, LDS_BYTES);
        (void)hipOccupancyMaxActiveBlocksPerMultiprocessor(&per_cu, (const void*)mega, NTHR, LDS_BYTES);
        if (per_cu < 1) { fprintf(stderr, "kernel_launch: occupancy query returned %d\n", per_cu); per_cu = 1; }
        if (per_cu > 1) per_cu = 1;
        grid_blocks = cus * per_cu;
        fprintf(stderr, "kernel_launch: cus %d per_cu %d grid %d\n", cus, per_cu, grid_blocks);
    }
    if (grid_blocks < 0) return;
    Ptrs p{};
    for (int i = 0; i < 19; ++i) p.in[i] = (const float*)d_in[i];
    p.out = (float*)d_out; p.ws = (unsigned char*)d_ws;
    (void)hipMemsetAsync((unsigned char*)d_ws + WS_CTL, 0, 16384, stream);
    void* args[] = {&p};
    hipError_t e = hipLaunchCooperativeKernel((const void*)mega, dim3(grid_blocks), dim3(NTHR), args, LDS_BYTES, stream);
    if (e != hipSuccess) fprintf(stderr, "cooperative launch failed: %s (grid %d)\n", hipGetErrorString(e), grid_blocks);
}
```
